# Optimizing an MI355X kernel written in HIP

```python
import math
import jax, jax.numpy as jnp
from jax import lax
import numpy as np

D_MODEL = 1024
BATCH = 8
SEQ = 4096
DEPTH = 2

CTX_LEN = 256
GRID_W = 64

HY_WIDTH = 512
SSM_WIDTH = 512
ATT_WIDTH = 512
D_MIX = HY_WIDTH + SSM_WIDTH + ATT_WIDTH

HY_SHORT = 3
HY_BANDS = 16
HY_EMB = 1 + 2 * HY_BANDS
HY_FILTER_HIDDEN = 64
HY_DECAY_TARGET = 1e-2
HY_FAST_PCT = 0.3
HY_SLOW_PCT = 1.5
HY_FILTER_OUT_SCALE = 0.05

SSM_HEADS = 8
SSM_HEADDIM = 64
SSM_GROUPS = 2
SSM_STATE = 128
SSM_CONV = 3
SSM_CHUNK = 128
SSM_CONV_DIM = SSM_WIDTH + 2 * SSM_GROUPS * SSM_STATE

ATT_HEADS = 8
ATT_KV_HEADS = 2
ATT_HEADDIM = 64
ATT_GROUP = ATT_HEADS // ATT_KV_HEADS
ATT_KV = ATT_KV_HEADS * ATT_HEADDIM
WINDOW = 128
ROPE_BASE = 10000.0

HY_IN = 4 * HY_WIDTH
SSM_IN = SSM_CONV_DIM + SSM_WIDTH + 2 * SSM_HEADS
ATT_IN = ATT_WIDTH + 2 * ATT_KV + ATT_WIDTH
N_IN = HY_IN + SSM_IN + ATT_IN

DEEPNORM_ALPHA = (2 * DEPTH) ** 0.25
DEEPNORM_BETA = (8 * DEPTH) ** -0.25
LN_EPS = 1e-6
RMS_EPS = 1e-5

kernel_name = "hymba_hyena_ssd_swa_prefix_dit"


def _layernorm(x):
    xf = x.astype(jnp.float32)
    mu = jnp.mean(xf, -1, keepdims=True)
    var = jnp.mean(jnp.square(xf - mu), -1, keepdims=True)
    return ((xf - mu) * lax.rsqrt(var + LN_EPS)).astype(x.dtype)


def _centred_dwconv(u, w, b):
    k = w.shape[0]
    pad = k // 2
    L = u.shape[1]
    up = jnp.pad(u, ((0, 0), (pad, pad), (0, 0)))
    out = up[:, 0:L] * w[0]
    for j in range(1, k):
        out = out + up[:, j:j + L] * w[j]
    return out + b


def _hyena_filters(L, w1, b1, w2, b2, w3, b3, freq, w_out):
    t = jnp.linspace(0.0, 1.0, L, dtype=jnp.float32)[:, None]
    w = 2.0 * math.pi * jnp.arange(L, dtype=jnp.float32)[:, None] / L
    f = jnp.linspace(1e-4, HY_BANDS - 1, HY_BANDS, dtype=jnp.float32)[None]
    z = jnp.concatenate([t, jnp.cos(f * w), -jnp.sin(f * w)], -1)
    h = jnp.sin(freq * (z @ w1 + b1))
    h = jnp.sin(freq * (h @ w2 + b2))
    h = jnp.sin(freq * (h @ w3 + b3))
    h = (h @ w_out).reshape(L, 2, 2, HY_WIDTH)
    max_decay = math.log(HY_DECAY_TARGET) / HY_FAST_PCT
    min_decay = math.log(HY_DECAY_TARGET) / HY_SLOW_PCT
    deltas = jnp.linspace(min_decay, max_decay, HY_WIDTH, dtype=jnp.float32)
    window = jnp.exp(-t * jnp.abs(deltas))
    h = h.astype(jnp.float32) * window[:, None, None, :]
    fwd, bwd = h[:, :, 0], h[:, :, 1]
    k_full = jnp.concatenate([fwd.at[0].add(bwd[0]), jnp.zeros_like(fwd[:1]), bwd[1:][::-1]], 0)
    return jnp.fft.rfft(k_full, axis=0)


def _long_conv(u, k_f, bias):
    L = u.shape[1]
    uf = u.astype(jnp.float32)
    y = jnp.fft.irfft(jnp.fft.rfft(uf, n=2 * L, axis=1) * k_f, n=2 * L, axis=1)[:, :L]
    return (y + uf * bias).astype(u.dtype)


def _hyena(u, conv_w, conv_b, filt_f, hy_bias):
    vxx = _centred_dwconv(u[..., :3 * HY_WIDTH], conv_w, conv_b)
    v, x1, x2 = jnp.split(vxx, 3, axis=-1)
    gate = u[..., 3 * HY_WIDTH:]
    y = x1 * _long_conv(v, filt_f[:, 0], hy_bias[0])
    y = x2 * _long_conv(y, filt_f[:, 1], hy_bias[1])
    return y * jax.nn.silu(gate)


def _ssd_scan(x, dt, a, B, C, init):
    b, L, h, p = x.shape
    n = B.shape[-1]
    nc = L // SSM_CHUNK
    f32 = jnp.float32
    xd = (x.astype(f32) * dt[..., None]).reshape(b, nc, SSM_CHUNK, h, p)
    da = (dt * a).reshape(b, nc, SSM_CHUNK, h)
    Bc = B.astype(f32).reshape(b, nc, SSM_CHUNK, h, n)
    Cc = C.astype(f32).reshape(b, nc, SSM_CHUNK, h, n)
    acs = jnp.cumsum(da, axis=2)
    seg = acs[:, :, :, None, :] - acs[:, :, None, :, :]
    lower = jnp.tril(jnp.ones((SSM_CHUNK, SSM_CHUNK), bool))[None, None, :, :, None]
    decay_ls = jnp.exp(jnp.where(lower, seg, -jnp.inf))
    y_diag = jnp.einsum("bclhn,bcshn,bclsh,bcshp->bclhp", Cc, Bc, decay_ls, xd)
    decay_to_end = jnp.exp(acs[:, :, -1:, :] - acs)
    chunk_states = jnp.einsum("bclhn,bclh,bclhp->bchpn", Bc, decay_to_end, xd)
    chunk_decay = jnp.exp(acs[:, :, -1, :])

    def step(s, inp):
        dec, st = inp
        return s * dec[:, :, None, None] + st, s

    final, states_in = lax.scan(step, init.astype(f32),
                                (jnp.moveaxis(chunk_decay, 1, 0), jnp.moveaxis(chunk_states, 1, 0)))
    states_in = jnp.moveaxis(states_in, 0, 1)
    y_off = jnp.einsum("bclhn,bchpn,bclh->bclhp", Cc, states_in, jnp.exp(acs))
    return (y_diag + y_off).reshape(b, L, h, p), final


def _ssd_prep(u, conv_w, conv_b, dt_bias, a_log):
    b, L, _ = u.shape
    gn = SSM_GROUPS * SSM_STATE
    xbc = jax.nn.silu(_centred_dwconv(u[..., :SSM_CONV_DIM], conv_w, conv_b))
    xs = xbc[..., :SSM_WIDTH].reshape(b, L, SSM_HEADS, SSM_HEADDIM)
    rep = SSM_HEADS // SSM_GROUPS
    Bh = jnp.repeat(xbc[..., SSM_WIDTH:SSM_WIDTH + gn].reshape(b, L, SSM_GROUPS, SSM_STATE), rep, axis=2)
    Ch = jnp.repeat(xbc[..., SSM_WIDTH + gn:].reshape(b, L, SSM_GROUPS, SSM_STATE), rep, axis=2)
    gate = u[..., SSM_CONV_DIM:SSM_CONV_DIM + SSM_WIDTH]
    dt_raw = u[..., SSM_CONV_DIM + SSM_WIDTH:].reshape(b, L, 2, SSM_HEADS)
    dt = jax.nn.softplus(dt_raw.astype(jnp.float32) + dt_bias.astype(jnp.float32))
    a = -jnp.exp(a_log.astype(jnp.float32))
    return xs, Bh, Ch, gate, dt, a


def _ssd_bidir(xs, Bh, Ch, dt, a, init_f, init_b):
    flip = lambda t: t[:, ::-1]
    y_f, s_f = _ssd_scan(xs, dt[:, :, 0], a[0], Bh, Ch, init_f)
    y_b, s_b = _ssd_scan(flip(xs), flip(dt[:, :, 1]), a[1], flip(Bh), flip(Ch), init_b)
    return y_f + flip(y_b), s_f, s_b


def _ssd_finish(y, xs, gate, d_skip, norm_w):
    b, L = xs.shape[:2]
    y = (y + xs.astype(jnp.float32) * d_skip[:, None]).reshape(b, L, SSM_WIDTH)
    y = y * jax.nn.silu(gate.astype(jnp.float32))
    yg = y.reshape(b, L, SSM_GROUPS, SSM_WIDTH // SSM_GROUPS)
    yg = yg * lax.rsqrt(jnp.mean(jnp.square(yg), -1, keepdims=True) + RMS_EPS)
    return yg.reshape(b, L, SSM_WIDTH).astype(gate.dtype) * norm_w


def _axial_angles(L):
    rows = L // GRID_W
    row = jnp.broadcast_to(jnp.arange(rows)[:, None], (rows, GRID_W)).reshape(L)
    col = jnp.broadcast_to(jnp.arange(GRID_W)[None, :], (rows, GRID_W)).reshape(L)
    nf = ATT_HEADDIM // 4
    inv = ROPE_BASE ** (-jnp.arange(nf, dtype=jnp.float32) / nf)
    ang = jnp.stack([row, col], -1).astype(jnp.float32)[:, :, None] * inv
    return jnp.cos(ang), jnp.sin(ang)


def _apply_rope(x, cos, sin):
    b, L, h, d = x.shape
    xr = x.astype(jnp.float32).reshape(b, L, h, 2, 2, d // 4)
    x1, x2 = xr[..., 0, :], xr[..., 1, :]
    c = cos[None, :, None]
    s = sin[None, :, None]
    out = jnp.stack([x1 * c - x2 * s, x1 * s + x2 * c], axis=-2)
    return out.reshape(b, L, h, d).astype(x.dtype)


def _attn_split(u):
    b, L, _ = u.shape
    q = u[..., :ATT_WIDTH].reshape(b, L, ATT_HEADS, ATT_HEADDIM)
    k = u[..., ATT_WIDTH:ATT_WIDTH + ATT_KV].reshape(b, L, ATT_KV_HEADS, ATT_HEADDIM)
    v = u[..., ATT_WIDTH + ATT_KV:ATT_WIDTH + 2 * ATT_KV].reshape(b, L, ATT_KV_HEADS, ATT_HEADDIM)
    gate = u[..., ATT_WIDTH + 2 * ATT_KV:]
    return q, k, v, gate


def _ctx_attention(q, k, v, sinks):
    b, L = q.shape[:2]
    scale = ATT_HEADDIM ** -0.5
    qg = q.reshape(b, L, ATT_KV_HEADS, ATT_GROUP, ATT_HEADDIM)
    s = jnp.einsum("bqhgd,bkhd->bhgqk", qg, k).astype(jnp.float32) * scale
    sink = jnp.broadcast_to(sinks.astype(jnp.float32).reshape(ATT_KV_HEADS, ATT_GROUP, 1, 1),
                            (b, ATT_KV_HEADS, ATT_GROUP, L, 1))
    p = jax.nn.softmax(jnp.concatenate([s, sink], -1), axis=-1)[..., :-1]
    o = jnp.einsum("bhgqk,bkhd->bqhgd", p.astype(v.dtype), v)
    return o.reshape(b, L, ATT_WIDTH)


def _window_attention(q, k, v, kc, vc, sinks):
    b, L = q.shape[:2]
    nb = L // WINDOW
    nloc = 3 * WINDOW
    lc = kc.shape[1]
    scale = ATT_HEADDIM ** -0.5
    qb = q.reshape(b, nb, WINDOW, ATT_KV_HEADS, ATT_GROUP, ATT_HEADDIM)
    pad = ((0, 0), (WINDOW, WINDOW), (0, 0), (0, 0))
    kp = jnp.pad(k, pad).reshape(b, nb + 2, WINDOW, ATT_KV_HEADS, ATT_HEADDIM)
    vp = jnp.pad(v, pad).reshape(b, nb + 2, WINDOW, ATT_KV_HEADS, ATT_HEADDIM)
    kband = jnp.concatenate([kp[:, :-2], kp[:, 1:-1], kp[:, 2:]], axis=2)
    vband = jnp.concatenate([vp[:, :-2], vp[:, 1:-1], vp[:, 2:]], axis=2)
    qi = jnp.arange(WINDOW)[:, None]
    kj = jnp.arange(nloc)[None, :] - WINDOW
    kpos = jnp.arange(nb)[:, None, None] * WINDOW + kj[None]
    mask = (jnp.abs(qi - kj) <= WINDOW)[None] & (kpos >= 0) & (kpos < L)
    s_loc = jnp.einsum("bnqhgd,bnkhd->bnhgqk", qb, kband).astype(jnp.float32) * scale
    s_loc = jnp.where(mask[None, :, None, None], s_loc, -jnp.inf)
    s_ctx = jnp.einsum("bnqhgd,bkhd->bnhgqk", qb, kc).astype(jnp.float32) * scale
    sink = jnp.broadcast_to(sinks.astype(jnp.float32).reshape(1, 1, ATT_KV_HEADS, ATT_GROUP, 1, 1),
                            (b, nb, ATT_KV_HEADS, ATT_GROUP, WINDOW, 1))
    p = jax.nn.softmax(jnp.concatenate([s_loc, s_ctx, sink], -1), axis=-1).astype(v.dtype)
    o = (jnp.einsum("bnhgqk,bnkhd->bnqhgd", p[..., :nloc], vband)
         + jnp.einsum("bnhgqk,bkhd->bnqhgd", p[..., nloc:nloc + lc], vc))
    return o.reshape(b, L, ATT_WIDTH)


def _modulate(x, shift, scale):
    return _layernorm(x) * (1.0 + scale) + shift


def setup_inputs(seed: int = 0) -> dict:
    key = jax.random.key(seed)
    ks = jax.random.split(key, 32)
    f32 = jnp.float32

    def nrm(k, shape, s):
        return jax.random.normal(k, shape, f32) * s

    dt0 = jnp.exp(jax.random.uniform(ks[20], (DEPTH, 2, SSM_HEADS), f32, math.log(1e-3), math.log(1e-1)))
    return {
        "x": nrm(ks[0], (BATCH, SEQ, D_MODEL), 1.0),
        "c": nrm(ks[1], (BATCH, D_MODEL), 1.0),
        "ctx": nrm(ks[2], (BATCH, CTX_LEN, D_MODEL), 1.0),
        "c_ctx": nrm(ks[3], (D_MODEL,), 1.0),
        "w_mod": nrm(ks[4], (DEPTH, D_MODEL, 3 * D_MODEL), D_MODEL ** -0.5),
        "b_mod": nrm(ks[5], (DEPTH, 3 * D_MODEL), 0.02),
        "w_in": nrm(ks[6], (DEPTH, D_MODEL, N_IN), D_MODEL ** -0.5),
        "hy_conv_w": nrm(ks[7], (DEPTH, HY_SHORT, 3 * HY_WIDTH), HY_SHORT ** -0.5),
        "hy_conv_b": nrm(ks[8], (DEPTH, 3 * HY_WIDTH), 0.02),
        "hy_f_w1": nrm(ks[9], (DEPTH, HY_EMB, HY_FILTER_HIDDEN), HY_EMB ** -0.5),
        "hy_f_b1": nrm(ks[10], (DEPTH, HY_FILTER_HIDDEN), 0.02),
        "hy_f_w2": nrm(ks[11], (DEPTH, HY_FILTER_HIDDEN, HY_FILTER_HIDDEN), HY_FILTER_HIDDEN ** -0.5),
        "hy_f_b2": nrm(ks[12], (DEPTH, HY_FILTER_HIDDEN), 0.02),
        "hy_f_w3": nrm(ks[13], (DEPTH, HY_FILTER_HIDDEN, HY_FILTER_HIDDEN), HY_FILTER_HIDDEN ** -0.5),
        "hy_f_b3": nrm(ks[14], (DEPTH, HY_FILTER_HIDDEN), 0.02),
        "hy_f_freq": 1.0 + nrm(ks[15], (DEPTH, HY_FILTER_HIDDEN), 0.05),
        "hy_f_wout": nrm(ks[16], (DEPTH, HY_FILTER_HIDDEN, 4 * HY_WIDTH), HY_FILTER_OUT_SCALE * HY_FILTER_HIDDEN ** -0.5),
        "hy_bias": nrm(ks[17], (DEPTH, 2, HY_WIDTH), 0.1),
        "ssm_conv_w": nrm(ks[18], (DEPTH, SSM_CONV, SSM_CONV_DIM), SSM_CONV ** -0.5),
        "ssm_conv_b": nrm(ks[19], (DEPTH, SSM_CONV_DIM), 0.02),
        "ssm_dt_bias": dt0 + jnp.log(-jnp.expm1(-dt0)),
        "ssm_a_log": jnp.log(jax.random.uniform(ks[21], (DEPTH, 2, SSM_HEADS), f32, 1.0, 16.0)),
        "ssm_d": 1.0 + nrm(ks[22], (DEPTH, SSM_HEADS), 0.1),
        "ssm_norm_w": 1.0 + nrm(ks[23], (DEPTH, SSM_WIDTH), 0.05),
        "attn_sinks": nrm(ks[24], (DEPTH, ATT_HEADS), 0.5),
        "w_out": nrm(ks[25], (DEPTH, D_MIX, D_MODEL), DEEPNORM_BETA * D_MIX ** -0.5),
        "ln_g": 1.0 + nrm(ks[26], (DEPTH, D_MODEL), 0.05),
        "ln_b": nrm(ks[27], (DEPTH, D_MODEL), 0.02),
    }


def reference(x, c, ctx, c_ctx, w_mod, b_mod, w_in, hy_conv_w, hy_conv_b, hy_f_w1, hy_f_b1,
              hy_f_w2, hy_f_b2, hy_f_w3, hy_f_b3, hy_f_freq, hy_f_wout, hy_bias, ssm_conv_w,
              ssm_conv_b, ssm_dt_bias, ssm_a_log, ssm_d, ssm_norm_w, attn_sinks, w_out, ln_g, ln_b):
    b, L, _ = x.shape
    lc = ctx.shape[1]
    cos, sin = _axial_angles(L)
    h_lat, h_ctx = x, ctx
    for i in range(DEPTH):
        ctx_needed = i < DEPTH - 1
        mod = jax.nn.silu(c) @ w_mod[i] + b_mod[i]
        mod_c = jax.nn.silu(c_ctx) @ w_mod[i] + b_mod[i]
        sh, sc, g = jnp.split(mod[:, None, :], 3, axis=-1)
        sh_c, sc_c, g_c = jnp.split(mod_c, 3, axis=-1)
        u = _modulate(h_lat, sh, sc) @ w_in[i]
        uc = _modulate(h_ctx, sh_c, sc_c) @ w_in[i]
        u_hy, u_ss, u_at = u[..., :HY_IN], u[..., HY_IN:HY_IN + SSM_IN], u[..., HY_IN + SSM_IN:]
        uc_hy, uc_ss, uc_at = uc[..., :HY_IN], uc[..., HY_IN:HY_IN + SSM_IN], uc[..., HY_IN + SSM_IN:]

        filt_args = (hy_f_w1[i], hy_f_b1[i], hy_f_w2[i], hy_f_b2[i], hy_f_w3[i], hy_f_b3[i],
                     hy_f_freq[i], hy_f_wout[i])
        y_hy = _hyena(u_hy, hy_conv_w[i], hy_conv_b[i], _hyena_filters(L, *filt_args), hy_bias[i])

        xs_c, B_c, C_c, z_c, dt_c, a = _ssd_prep(uc_ss, ssm_conv_w[i], ssm_conv_b[i], ssm_dt_bias[i], ssm_a_log[i])
        zero_state = jnp.zeros((b, SSM_HEADS, SSM_HEADDIM, SSM_STATE), jnp.float32)
        y_ss_c, s_f, s_b = _ssd_bidir(xs_c, B_c, C_c, dt_c, a, zero_state, zero_state)
        xs, Bh, Ch, z_s, dt, a = _ssd_prep(u_ss, ssm_conv_w[i], ssm_conv_b[i], ssm_dt_bias[i], ssm_a_log[i])
        y_ss, _, _ = _ssd_bidir(xs, Bh, Ch, dt, a, s_f, s_b)
        y_ss = _ssd_finish(y_ss, xs, z_s, ssm_d[i], ssm_norm_w[i])

        q, k, v, z_a = _attn_split(u_at)
        q, k = _apply_rope(q, cos, sin), _apply_rope(k, cos, sin)
        qc, kc, vc, z_ac = _attn_split(uc_at)
        y_at = _window_attention(q, k, v, kc, vc, attn_sinks[i]) * jax.nn.silu(z_a)

        out = jnp.concatenate([y_hy, y_ss, y_at], axis=-1) @ w_out[i]
        new_lat = _layernorm(DEEPNORM_ALPHA * h_lat + g * out) * ln_g[i] + ln_b[i]

        if ctx_needed:
            y_hy_c = _hyena(uc_hy, hy_conv_w[i], hy_conv_b[i], _hyena_filters(lc, *filt_args), hy_bias[i])
            y_ss_c = _ssd_finish(y_ss_c, xs_c, z_c, ssm_d[i], ssm_norm_w[i])
            y_at_c = _ctx_attention(qc, kc, vc, attn_sinks[i]) * jax.nn.silu(z_ac)
            out_c = jnp.concatenate([y_hy_c, y_ss_c, y_at_c], axis=-1) @ w_out[i]
            h_ctx = _layernorm(DEEPNORM_ALPHA * h_ctx + g_c * out_c) * ln_g[i] + ln_b[i]
        h_lat = new_lat
    return h_lat
```

```cpp
#include <hip/hip_runtime.h>
#include <cstdio>
#include <cstdint>
namespace pg8 {
#define PG8_LAS __attribute__((address_space(3)))
typedef unsigned short bf16_t;
typedef short bf16x8 __attribute__((ext_vector_type(8)));
typedef float f32x4 __attribute__((ext_vector_type(4)));
typedef unsigned u32x4 __attribute__((ext_vector_type(4)));
constexpr int BM = 256, BK = 64, HALF = 128, HTB = HALF * BK * 2  , STAGE_BYTES = 8 * HTB, NXCD = 8, WGM = 8;

__host__ __device__ __forceinline__ int lds_byte(int r, int c) { const int st = (r >> 4) * 2 + (c >> 5), rr = r & 15, cc = c & 31, ob = rr * 64 + cc * 2; return st * 1024 + (ob ^ (((ob >> 9) & 1) << 5)); }
__host__ __device__ __forceinline__ void stage_rc(int b, int& R, int& C) { const int st = b / 1024, sb = b % 1024, swz = sb ^ (((sb >> 9) & 1) << 5); R = (st >> 1) * 16 + swz / 64; C = (st & 1) * 32 + (swz % 64) / 2; }
__host__ __device__ __forceinline__ int perm32(int rho) { const int n = rho >> 4, i = rho & 15; return 8 * (i >> 2) + 4 * n + (i & 3); }

struct Unit { int pm, pn; };
struct Gemm { const bf16_t* A; const bf16_t* Bt; int M, N, K; };

struct StaticOrder {
    int nM, nN, nwg, G, c;
    __host__ __device__ void init(int M, int N, int G_, int c_) { nM = M / BM; nN = N / BM; nwg = nM * nN; G = G_; c = c_; }
    __host__ __device__ bool next(int i, Unit& u) const {
        const long L = (long)i * G + c; if (L >= nwg) return false;
        int wgid = (int)L; { const int q = nwg / NXCD, r = nwg % NXCD, xcd = wgid % NXCD, off = wgid / NXCD; wgid = (xcd < r ? xcd * (q + 1) : r * (q + 1) + (xcd - r) * q) + off; }
        const int nig = WGM * nN, gid = wgid / nig, fm = gid * WGM, gsz = (nM - fm) < WGM ? (nM - fm) : WGM;
        u.pm = fm + ((wgid % nig) % gsz); u.pn = (wgid % nig) / gsz; return true;
    }
    __device__ __forceinline__ void a_ready(const Unit&) const {}
    __device__ __forceinline__ void done(const Unit&) const {}
};

__device__ __forceinline__ unsigned cvt_pk_bf16(float lo, float hi) { unsigned r; asm volatile("v_cvt_pk_bf16_f32 %0, %1, %2" : "=v"(r) : "v"(lo), "v"(hi)); return r; }
struct EpiBf16 {
    static constexpr bool PERM = true, AFTER_DRAIN = false;
    bf16_t* O; int ldc;
    __device__ __forceinline__ void operator()(const f32x4 (&acc)[2][2][4][2], const Unit& u, int wr, int wc, int fr, int fq) const {
        asm volatile("" : "+v"(fr), "+v"(fq));
        const int row0 = u.pm * BM + wr * 64 + fr; const int col0 = u.pn * BM + wc * 32 + 8 * fq;
#pragma unroll
        for (int ai = 0; ai < 2; ++ai)
#pragma unroll
            for (int m = 0; m < 4; ++m) { bf16_t* rowp = O + (size_t)(row0 + ai * HALF + m * 16) * ldc + col0;
#pragma unroll
                for (int bj = 0; bj < 2; ++bj) { const f32x4 v0 = acc[ai][bj][m][0], v1 = acc[ai][bj][m][1];
                    u32x4 w; w.x = cvt_pk_bf16(v0[0], v0[1]); w.y = cvt_pk_bf16(v0[2], v0[3]); w.z = cvt_pk_bf16(v1[0], v1[1]); w.w = cvt_pk_bf16(v1[2], v1[3]);
                    *(u32x4*)(rowp + bj * HALF) = w; } }
    }
};
struct EpiRes {
    static constexpr bool PERM = false, AFTER_DRAIN = false;
    const float* xlat; const float* xctx; const float* mod; float* T; int layer;
    __device__ __forceinline__ void operator()(const f32x4 (&acc)[2][2][4][2], const Unit& u, int wr, int wc, int fr, int fq) const {
        asm volatile("" : "+v"(fr), "+v"(fq));
        const int pm = u.pm, hf = pm / 68, pr = pm % 68;
        const float* src; const float* gv;
        if (pr < 64) { const int b = hf * 4 + (pr >> 4); src = xlat + ((size_t)b * 4096 + (size_t)(pr & 15) * 256) * 1024; gv = mod + (size_t)(layer * 9 + b) * 3072 + 2048; }
        else { const int b = hf * 4 + (pr - 64); src = xctx + (size_t)b * 256 * 1024; gv = mod + (size_t)(layer * 9 + 8) * 3072 + 2048; }
        const int col0 = u.pn * BM + wc * 32 + 4 * fq;
        const float alpha = 1.41421356237f;
#pragma unroll
        for (int bj = 0; bj < 2; ++bj)
#pragma unroll
            for (int n = 0; n < 2; ++n) { const int col = col0 + bj * HALF + n * 16; const f32x4 g4 = *(const f32x4*)(gv + col);
#pragma unroll
                for (int ai = 0; ai < 2; ++ai)
#pragma unroll
                    for (int m = 0; m < 4; ++m) { const int r = ai * HALF + wr * 64 + m * 16 + fr;
                        const f32x4 xs = *(const f32x4*)(src + (size_t)r * 1024 + col);
                        *(f32x4*)(T + ((size_t)pm * BM + r) * 1024 + col) = xs * alpha + g4 * acc[ai][bj][m][n]; } }
    }
};
struct OrderLat {
    StaticOrder S;
    __device__ __forceinline__ bool next(int i, Unit& u) const { if (!S.next(i, u)) return false; u.pm = (u.pm >> 6) * 68 + (u.pm & 63); return true; }
    __device__ __forceinline__ void a_ready(const Unit&) const {}
    __device__ __forceinline__ void done(const Unit&) const {}
};
template <class Epi, class Sched, bool ALIGN_EPI = false, bool SP2 = false>
__device__ __forceinline__ void gemm_phase(PG8_LAS unsigned char* lds, const Gemm g, const Sched& S, const Epi& E) {
    int tid_ = threadIdx.x; asm volatile("" : "+v"(tid_));
    const int tid = tid_, wid = __builtin_amdgcn_readfirstlane(tid >> 6), lane = tid & 63, wr = wid >> 2, wc = wid & 3, fr = lane & 15, fq = lane >> 4;
    const int K = g.K, nt = K / BK;
    unsigned voffA[2], voffB[2];
#pragma unroll
    for (int i = 0; i < 2; ++i) { int R, C; stage_rc(tid * 16 + i * 8192, R, C); const int Rb = Epi::PERM ? ((R & ~31) + perm32(R & 31)) : R;
        voffA[i] = (unsigned)(R * K + C) * 2u; voffB[i] = (unsigned)(Rb * K + C) * 2u; }
    const size_t kstep = (size_t)(BK * 2);
    const size_t hstep = (size_t)HALF * K * 2;
    const size_t tstep = 2 * hstep;
    const unsigned ldsw = (unsigned)wid * 1024u;
    const int aoff = lds_byte(wr * 64 + fr, fq * 8), boff = lds_byte(wc * 32 + fr, fq * 8);
#define PG8_SA(b, h) (((b) * 2 + (h)) * HTB)
#define PG8_SB(b, h) ((4 + (b) * 2 + (h)) * HTB)
#define PG8_STAGE(bufoff, gbase, voff) do { _Pragma("unroll") for (int _i = 0; _i < 2; ++_i) \
        __builtin_amdgcn_global_load_lds((const unsigned*)((const char*)(gbase) + (voff)[_i]), (PG8_LAS unsigned*)(lds + (bufoff) + ldsw + _i * 8192), 16, 0, 0); } while (0)
#define PG8_LDA(dst, b, h) do { _Pragma("unroll") for (int m = 0; m < 4; ++m) _Pragma("unroll") for (int k = 0; k < 2; ++k) dst[m][k] = *(const PG8_LAS bf16x8*)(lds + PG8_SA(b, h) + aoff + m * 2048 + k * 1024); } while (0)
#define PG8_LDB(dst, b, h) do { _Pragma("unroll") for (int n = 0; n < 2; ++n) _Pragma("unroll") for (int k = 0; k < 2; ++k) dst[n][k] = *(const PG8_LAS bf16x8*)(lds + PG8_SB(b, h) + boff + n * 2048 + k * 1024); } while (0)
#define PG8_MMA(ai, bj, At, Bt) do { __builtin_amdgcn_s_setprio(1); _Pragma("unroll") for (int m = 0; m < 4; ++m) _Pragma("unroll") for (int n = 0; n < 2; ++n) _Pragma("unroll") for (int k = 0; k < 2; ++k) \
        acc[ai][bj][m][n] = __builtin_amdgcn_mfma_f32_16x16x32_bf16(Bt[n][k], At[m][k], acc[ai][bj][m][n], 0, 0, 0); __builtin_amdgcn_s_setprio(0); } while (0)
#define PG8_WAIT_V(n) asm volatile("s_waitcnt vmcnt(" #n ")" ::: "memory")
#define PG8_WAIT_L(n) asm volatile("s_waitcnt lgkmcnt(" #n ")" ::: "memory")
#define PG8_BAR __builtin_amdgcn_s_barrier()
#define PG8_SCHED __builtin_amdgcn_sched_barrier(0)
    Unit cur, nxt; int ui = 0;
    if (!S.next(0, cur)) return;
    f32x4 acc[2][2][4][2];
#pragma unroll
    for (int a = 0; a < 2; ++a)
#pragma unroll
        for (int b = 0; b < 2; ++b)
#pragma unroll
            for (int m = 0; m < 4; ++m)
#pragma unroll
                for (int n = 0; n < 2; ++n) acc[a][b][m][n] = (f32x4){0.f, 0.f, 0.f, 0.f};
    bf16x8 At[4][2], B0[2][2], B1[2][2];
    const char* cA = (const char*)g.A + (size_t)cur.pm * tstep; const char* cB = (const char*)g.Bt + (size_t)cur.pn * tstep;
    S.a_ready(cur);
    if constexpr (SP2) {
        PG8_STAGE(PG8_SB(0, 0), cB, voffB); PG8_STAGE(PG8_SB(0, 1), cB + hstep, voffB); PG8_STAGE(PG8_SA(0, 0), cA, voffA); PG8_STAGE(PG8_SA(0, 1), cA + hstep, voffA);
        if (wr == 1) PG8_BAR;
        PG8_WAIT_V(2); PG8_BAR;
        PG8_STAGE(PG8_SB(1, 0), cB + kstep, voffB); PG8_STAGE(PG8_SA(1, 0), cA + kstep, voffA); PG8_STAGE(PG8_SB(1, 1), cB + hstep + kstep, voffB);
        PG8_WAIT_V(6); PG8_BAR;
    } else {
        PG8_STAGE(PG8_SB(0, 0), cB, voffB); PG8_STAGE(PG8_SA(0, 0), cA, voffA); PG8_STAGE(PG8_SB(0, 1), cB + hstep, voffB); PG8_STAGE(PG8_SA(0, 1), cA + hstep, voffA);
        if (wr == 1) PG8_BAR;
        PG8_WAIT_V(4); PG8_BAR;
        PG8_STAGE(PG8_SB(1, 0), cB + kstep, voffB); PG8_STAGE(PG8_SA(1, 0), cA + kstep, voffA); PG8_STAGE(PG8_SB(1, 1), cB + hstep + kstep, voffB);
        PG8_WAIT_V(6); PG8_BAR;
    }
    for (;;) {
        const bool has_next = S.next(ui + 1, nxt);
        const char* nA = has_next ? (const char*)g.A + (size_t)nxt.pm * tstep : cA; const char* nB = has_next ? (const char*)g.Bt + (size_t)nxt.pn * tstep : cB;
        for (int t = 0; t < nt; t += 2) {
            const bool last = (t == nt - 2);
            const char* a1 = cA + (size_t)(t + 1) * kstep;
            const char* a2 = last ? nA : cA + (size_t)(t + 2) * kstep; const char* b2 = last ? nB : cB + (size_t)(t + 2) * kstep;
            const char* a3 = a2 + kstep; const char* b3 = b2 + kstep;
            if (last && has_next) S.a_ready(nxt);
            if constexpr (SP2) {
            PG8_LDB(B0, 0, 0); PG8_LDB(B1, 0, 1); PG8_SCHED; PG8_LDA(At, 0, 0); PG8_STAGE(PG8_SA(1, 1), a1 + hstep, voffA);
            PG8_WAIT_V(8); PG8_WAIT_L(0); PG8_BAR; PG8_MMA(0, 0, At, B0); PG8_MMA(0, 1, At, B1); PG8_BAR; PG8_SCHED;
            PG8_LDA(At, 0, 1); PG8_STAGE(PG8_SB(0, 0), b2, voffB); PG8_STAGE(PG8_SB(0, 1), b2 + hstep, voffB); PG8_STAGE(PG8_SA(0, 0), a2, voffA);
            PG8_WAIT_V(8); PG8_WAIT_L(0); PG8_BAR; PG8_MMA(1, 0, At, B0); PG8_MMA(1, 1, At, B1); PG8_BAR; PG8_SCHED;
            PG8_LDB(B0, 1, 0); PG8_LDB(B1, 1, 1); PG8_SCHED; PG8_LDA(At, 1, 0); PG8_STAGE(PG8_SA(0, 1), a2 + hstep, voffA);
            PG8_WAIT_V(8); PG8_WAIT_L(0); PG8_BAR; PG8_MMA(0, 0, At, B0); PG8_MMA(0, 1, At, B1); PG8_BAR; PG8_SCHED;
            PG8_LDA(At, 1, 1); PG8_STAGE(PG8_SB(1, 0), b3, voffB); PG8_STAGE(PG8_SB(1, 1), b3 + hstep, voffB); PG8_STAGE(PG8_SA(1, 0), a3, voffA);
            PG8_WAIT_V(8); PG8_WAIT_L(0); PG8_BAR; PG8_MMA(1, 0, At, B0); PG8_MMA(1, 1, At, B1); PG8_BAR; PG8_SCHED;
            } else {
            PG8_LDB(B0, 0, 0); PG8_SCHED; PG8_LDA(At, 0, 0); PG8_STAGE(PG8_SA(1, 1), a1 + hstep, voffA);
            PG8_WAIT_L(8); PG8_BAR; PG8_WAIT_L(0); PG8_MMA(0, 0, At, B0); PG8_BAR; PG8_SCHED;
            PG8_LDB(B1, 0, 1); PG8_STAGE(PG8_SB(0, 0), b2, voffB);
            PG8_BAR; PG8_WAIT_L(0); PG8_MMA(0, 1, At, B1); PG8_BAR;
            PG8_LDA(At, 0, 1); PG8_STAGE(PG8_SA(0, 0), a2, voffA);
            PG8_BAR; PG8_WAIT_L(0); PG8_MMA(1, 0, At, B0); PG8_BAR; PG8_SCHED;
            PG8_STAGE(PG8_SB(0, 1), b2 + hstep, voffB);
            PG8_WAIT_V(6); PG8_BAR; PG8_MMA(1, 1, At, B1); PG8_BAR;
            PG8_LDB(B0, 1, 0); PG8_SCHED; PG8_LDA(At, 1, 0); PG8_STAGE(PG8_SA(0, 1), a2 + hstep, voffA);
            PG8_WAIT_L(8); PG8_BAR; PG8_WAIT_L(0); PG8_MMA(0, 0, At, B0); PG8_BAR; PG8_SCHED;
            PG8_LDB(B1, 1, 1); PG8_STAGE(PG8_SB(1, 0), b3, voffB);
            PG8_BAR; PG8_WAIT_L(0); PG8_MMA(0, 1, At, B1); PG8_BAR;
            PG8_LDA(At, 1, 1); PG8_STAGE(PG8_SA(1, 0), a3, voffA);
            PG8_BAR; PG8_WAIT_L(0); PG8_MMA(1, 0, At, B0); PG8_BAR; PG8_SCHED;
            PG8_STAGE(PG8_SB(1, 1), b3 + hstep, voffB);
            PG8_WAIT_V(6); PG8_BAR; PG8_MMA(1, 1, At, B1); PG8_BAR;
            }
        }
        if constexpr (ALIGN_EPI) { if (wr == 0) PG8_BAR; }
        if constexpr (!Epi::AFTER_DRAIN) { E(acc, cur, wr, wc, fr, fq); S.done(cur); }
        if (!has_next) break;
#pragma unroll
        for (int a = 0; a < 2; ++a)
#pragma unroll
            for (int b = 0; b < 2; ++b)
#pragma unroll
                for (int m = 0; m < 4; ++m)
#pragma unroll
                    for (int n = 0; n < 2; ++n) acc[a][b][m][n] = (f32x4){0.f, 0.f, 0.f, 0.f};
        cur = nxt; cA = nA; cB = nB; ++ui;
        if constexpr (ALIGN_EPI) { if (wr == 1) PG8_BAR; }
    }
    PG8_WAIT_V(0);
    if constexpr (!ALIGN_EPI) { if (wr == 0) PG8_BAR; }
    PG8_BAR;
    if constexpr (Epi::AFTER_DRAIN) { E.fused(acc, cur, wr, wc, fr, fq, lds, wid, lane); S.done(cur); }
#undef PG8_SA
#undef PG8_SB
#undef PG8_STAGE
#undef PG8_LDA
#undef PG8_LDB
#undef PG8_MMA
#undef PG8_WAIT_V
#undef PG8_WAIT_L
#undef PG8_BAR
#undef PG8_SCHED
}
}
constexpr int DM = 1024, NBATCH = 8, SEQ = 4096, LCTX = 256, NIN = 4880;
constexpr int HLAT = 4 * SEQ, HCTX = 4 * LCTX, HROWS = HLAT + HCTX  , MTOT = 2 * HROWS  ;
constexpr int UR_LD = 3072, Y_LD = 1536;
constexpr int UR_Z = 1024, UR_DT = 1536, UR_Q = 1792, UR_K = 2304, UR_V = 2432, UR_ZA = 2560;
constexpr int NWAVES = 8, NTHR = 512;
constexpr size_t MiB = 1u << 20;
constexpr size_t WS_CTL = 0, CTL_ZERO_BYTES = 1 * MiB;
constexpr size_t WS_MOD = 1 * MiB;
constexpr size_t WS_ROPE = 1 * MiB + 256 * 1024;
constexpr size_t WS_TW = 1 * MiB + 512 * 1024;
constexpr size_t WS_H3 = 2 * MiB;
constexpr size_t WS_KC = 5 * MiB;
constexpr size_t WS_WHY = 8 * MiB;
constexpr size_t WS_WR = 16 * MiB;
constexpr size_t WS_WO = 28 * MiB;
constexpr size_t WS_SPEC = 36 * MiB;
constexpr int SPEC_LD = 4104;
constexpr size_t WS_XN = 101 * MiB;
constexpr size_t WS_Y = 169 * MiB;
constexpr size_t WS_UHY = 271 * MiB;
constexpr size_t WS_UR = 339 * MiB;
constexpr size_t WS_T = 271 * MiB;
constexpr size_t WS_KFULL = 271 * MiB;
constexpr size_t WS_YF = 441 * MiB, WS_YB = 475 * MiB;
constexpr size_t WS_END = 509 * MiB;
constexpr int CW_BAR = 4096, CW_CTR = 16384;
constexpr int LDS_BYTES = 155648;
constexpr int LDSCTL_OFF = 154624;

#define GAS __attribute__((address_space(1)))
#define LAS __attribute__((address_space(3)))
typedef unsigned short bf16;
typedef unsigned v4u __attribute__((ext_vector_type(4)));
typedef unsigned v2u __attribute__((ext_vector_type(2)));
typedef float f32x4 __attribute__((ext_vector_type(4)));
typedef float f32x2 __attribute__((ext_vector_type(2)));
#define LDS_WAIT() asm volatile("s_waitcnt lgkmcnt(0)" ::: "memory")
__device__ __forceinline__ unsigned f2bf(float f) { unsigned u = __builtin_bit_cast(unsigned, f); return (u + 0x7fffu + ((u >> 16) & 1u)) >> 16; }
__device__ __forceinline__ unsigned pk2(float lo, float hi) { return f2bf(lo) | (f2bf(hi) << 16); }
__device__ __forceinline__ float bf2f(unsigned short h) { return __builtin_bit_cast(float, (unsigned)h << 16); }
__device__ __forceinline__ float bflo(unsigned w) { return __builtin_bit_cast(float, w << 16); }
__device__ __forceinline__ float bfhi(unsigned w) { return __builtin_bit_cast(float, w & 0xffff0000u); }
__device__ __forceinline__ float siluf(float x) { return x / (1.f + __expf(-x)); }
__device__ __forceinline__ float wave_sum(float v) {
#pragma unroll
    for (int o = 1; o < 64; o <<= 1) v += __shfl_xor(v, o);
    return v;
}

#define XB_TMO      128
#define XB_XCNT(j)  (256  + 64 * (j))
#define XB_XSUB(j)  (1280 + 64 * (j))
#define XB_XGEN(j)  (2304 + 64 * (j))
#define XB_TOP      3328
#define XB_TOPGEN   3392
#define XCD_BAR_WORDS 3456
#define XB_SPIN_CAP (1u << 22)
__device__ __forceinline__ unsigned xb_ld(unsigned* p)              { return __hip_atomic_load(p, __ATOMIC_RELAXED, __HIP_MEMORY_SCOPE_AGENT); }
__device__ __forceinline__ unsigned xb_add(unsigned* p, unsigned v) { return __hip_atomic_fetch_add(p, v, __ATOMIC_RELAXED, __HIP_MEMORY_SCOPE_AGENT); }
__device__ __forceinline__ unsigned xb_xcc_id() { return (unsigned)__builtin_amdgcn_s_getreg((3 << 11) | 20) & 0xFu; }
#define XB_SPIN(cond, bar) do { unsigned _sp = 0; while (cond) { __builtin_amdgcn_s_sleep(1); \
    if ((++_sp & 255u) == 0u) { if (xb_ld(&(bar)[XB_TMO])) break; if (_sp > XB_SPIN_CAP) { atomicAdd(&(bar)[XB_TMO], 1u); break; } } } } while (0)
struct XcdBarrier { unsigned* bar; unsigned x; volatile LAS unsigned* st; };
__device__ __forceinline__ XcdBarrier xcd_barrier_post(unsigned* bar, volatile LAS unsigned* st) {
    XcdBarrier b; b.bar = bar; b.x = xb_xcc_id(); b.st = st;
    if (threadIdx.x == 0) (void)xb_add(&bar[XB_XCNT(b.x)], 1u);
    return b;
}
__device__ __forceinline__ void xcd_barrier_complete(unsigned* bar, unsigned x, unsigned& nloc, unsigned& nx) {
    const unsigned G = gridDim.x * gridDim.y * gridDim.z;
    unsigned sum, cnt, mine, sp = 0u;
    for (;;) {
        sum = 0u; cnt = 0u; mine = 0u;
#pragma unroll
        for (unsigned j = 0; j < 16; ++j) { const unsigned c = xb_ld(&bar[XB_XCNT(j)]); sum += c; cnt += (c > 0u) ? 1u : 0u; mine = (j == x) ? c : mine; }
        if (sum == G) break;
        __builtin_amdgcn_s_sleep(1);
        if ((++sp & 255u) == 0u) { if (xb_ld(&bar[XB_TMO])) break; if (sp > XB_SPIN_CAP) { atomicAdd(&bar[XB_TMO], 1u); break; } }
    }
    nloc = mine > 0u ? mine : 1u; nx = cnt > 0u ? cnt : 1u;
}
__device__ __forceinline__ void xcd_barrier(const XcdBarrier& b) {
    asm volatile("s_waitcnt vmcnt(0)" ::: "memory");
    __syncthreads();
    if (threadIdx.x == 0) {
        unsigned* bar = b.bar;
        __builtin_amdgcn_s_waitcnt(0);
        unsigned nloc = b.st[0], nx = b.st[1];
        if (nloc == 0u) { xcd_barrier_complete(bar, b.x, nloc, nx); b.st[0] = nloc; b.st[1] = nx; }
        const unsigned old = xb_add(&bar[XB_XSUB(b.x)], 1u);
        const unsigned gen = old / nloc;
        if (old + 1u == (gen + 1u) * nloc) {
            __builtin_amdgcn_fence(__ATOMIC_RELEASE, "agent");
            asm volatile("s_waitcnt vmcnt(0)" ::: "memory");
            const unsigned og = xb_add(&bar[XB_TOP], 1u);
            const unsigned tg = og / nx;
            if (og + 1u == (tg + 1u) * nx) xb_add(&bar[XB_TOPGEN], 1u);
            else XB_SPIN(xb_ld(&bar[XB_TOPGEN]) == tg, bar);
            __builtin_amdgcn_fence(__ATOMIC_ACQUIRE, "agent");
            xb_add(&bar[XB_XGEN(b.x)], 1u);
            asm volatile("s_waitcnt vmcnt(0)" ::: "memory");
        } else {
            XB_SPIN(xb_ld(&bar[XB_XGEN(b.x)]) == gen, bar);
            __builtin_amdgcn_fence(__ATOMIC_ACQUIRE, "agent");
            asm volatile("s_waitcnt vmcnt(0)" ::: "memory");
        }
    }
    __syncthreads();
}

struct Args { const float* in[28]; float* out; unsigned char* ws; int ph_lo, ph_hi; };
enum { I_X = 0, I_C, I_CTX, I_CCTX, I_WMOD, I_BMOD, I_WIN, I_HCW, I_HCB, I_FW1, I_FB1, I_FW2, I_FB2, I_FW3, I_FB3, I_FFREQ, I_FWOUT, I_HBIAS,
       I_SCW, I_SCB, I_DTB, I_ALOG, I_SD, I_SNW, I_SINK, I_WOUT, I_LNG, I_LNB };
struct Frame {
    LAS unsigned char* lds; int tid, lane, wave, bid, G;
    float* out; unsigned char* ws;
    __device__ __forceinline__ void refresh() {
        int t = threadIdx.x; asm volatile("" : "+v"(t)); tid = t; lane = t & 63; wave = __builtin_amdgcn_readfirstlane(t >> 6);
    }
};
__device__ __forceinline__ int next_tile(Frame& F, unsigned* ctr) {
    volatile LAS int* slot = (volatile LAS int*)(F.lds + LDSCTL_OFF + 64);
    __syncthreads();
    if (F.tid == 0) *slot = (int)atomicAdd(ctr, 1u);
    __syncthreads();
    return *slot;
}

__device__ __forceinline__ void p0_transpose_item(const float* W, int ldw, int K, int nblk, bf16* WT, int mode, LAS float* scr, int item, int lane) {
    const int kb = item / nblk, nb = item % nblk, k0 = 64 * kb, n0 = 32 * nb;
    const int r = n0 + (lane & 31);
    int src = r;
    if (mode == 1) src = (r < 1552) ? (2048 + r) : (r < 1792 ? -1 : 3600 + (r - 1792));
#pragma unroll 8
    for (int i = 0; i < 32; ++i) { const int kk = 2 * i + (lane >> 5); scr[kk * 33 + (lane & 31)] = (src >= 0) ? W[(size_t)(k0 + kk) * ldw + src] : 0.f; }
    LDS_WAIT(); asm volatile("" ::: "memory");
    const int c = lane & 7;
#pragma unroll
    for (int j = 0; j < 4; ++j) { const int n = (lane >> 3) + 8 * j; const LAS float* s = scr + (8 * c) * 33 + n;
        v4u o; o.x = pk2(s[0 * 33], s[1 * 33]); o.y = pk2(s[2 * 33], s[3 * 33]); o.z = pk2(s[4 * 33], s[5 * 33]); o.w = pk2(s[6 * 33], s[7 * 33]);
        *(v4u*)(WT + (size_t)(n0 + n) * K + k0 + 8 * c) = o; }
    LDS_WAIT(); asm volatile("" ::: "memory");
}
__device__ __forceinline__ void phase0(Frame& F, const Args& A) {
    F.refresh();
    const int gw = F.bid * NWAVES + F.wave, NGW = F.G * NWAVES;
    {
        LAS float* scr = (LAS float*)(F.lds + F.wave * 16384);
        constexpr int I_HY = 16 * 64, I_R = 16 * 96, I_O = 24 * 32, I_L = I_HY + I_R + I_O;
        for (int it = gw; it < 2 * I_L; it += NGW) {
            const int l = it / I_L; int r = it % I_L;
            const float* win = A.in[I_WIN] + (size_t)l * 1024 * NIN;
            if (r < I_HY) { p0_transpose_item(win, NIN, 1024, 64, (bf16*)(F.ws + WS_WHY) + (size_t)l * 2048 * 1024, 0, scr, r, F.lane); continue; } r -= I_HY;
            if (r < I_R) { p0_transpose_item(win, NIN, 1024, 96, (bf16*)(F.ws + WS_WR) + (size_t)l * 3072 * 1024, 1, scr, r, F.lane); continue; } r -= I_R;
            p0_transpose_item(A.in[I_WOUT] + (size_t)l * 1536 * 1024, 1024, 1536, 32, (bf16*)(F.ws + WS_WO) + (size_t)l * 1024 * 1536, 0, scr, r, F.lane);
        }
    }
    __syncthreads();
    {
        float* tw = (float*)(F.ws + WS_TW); float* rope = (float*)(F.ws + WS_ROPE);
        for (int j = F.bid * NTHR + F.tid; j < 4096; j += F.G * NTHR) { float s, c; sincospif((float)j * (1.0f / 4096.0f), &s, &c); tw[2 * j] = c; tw[2 * j + 1] = -s; }
        for (int j = F.bid * NTHR + F.tid; j < 1024; j += F.G * NTHR) { const int pos = j >> 4, i = j & 15;
            const float inv = exp2f(-(float)i * (13.287712379549449f / 16.0f)); const float ang = (float)pos * inv;
            rope[2 * j] = cosf(ang); rope[2 * j + 1] = sinf(ang); }
    }
    {
        LAS float* red = (LAS float*)F.lds;
        float* MOD = (float*)(F.ws + WS_MOD);
        for (int it = F.bid; it < 96; it += F.G) {
            const int l = it / 48, j0 = (it % 48) * 64, j = j0 + F.lane;
            float acc[9];
#pragma unroll
            for (int v = 0; v < 9; ++v) acc[v] = 0.f;
            const float* wm = A.in[I_WMOD] + (size_t)l * 1024 * 3072;
            for (int k = F.wave * 128; k < F.wave * 128 + 128; ++k) {
                const float w = wm[(size_t)k * 3072 + j];
#pragma unroll
                for (int v = 0; v < 9; ++v) { const float cv = (v < 8) ? A.in[I_C][v * 1024 + k] : A.in[I_CCTX][k]; acc[v] += siluf(cv) * w; }
            }
            __syncthreads();
#pragma unroll
            for (int v = 0; v < 9; ++v) red[(F.wave * 9 + v) * 64 + F.lane] = acc[v];
            __syncthreads();
            for (int idx = F.tid; idx < 576; idx += NTHR) { const int v = idx >> 6, ln = idx & 63; float s = A.in[I_BMOD][l * 3072 + j0 + ln];
#pragma unroll
                for (int w = 0; w < 8; ++w) s += red[(w * 9 + v) * 64 + ln];
                MOD[(size_t)(l * 9 + v) * 3072 + j0 + ln] = s; }
            __syncthreads();
        }
    }
    {
        LAS float* zs = (LAS float*)F.lds;
        LAS float* ha = zs + 512; LAS float* hb = ha + 512;
        float* H3 = (float*)(F.ws + WS_H3);
        for (int it = F.bid; it < 1088; it += F.G) {
            const int l = it / 544, tt0 = (it % 544) * 8, ti = F.tid >> 6, j = F.tid & 63, tt = tt0 + ti;
            const int L = tt < 4096 ? 4096 : 256, t = tt < 4096 ? tt : tt - 4096;
            __syncthreads();
            if (j < 33) {
                float z;
                if (j == 0) z = (float)t / (float)(L - 1);
                else { const int i = (j - 1) & 15; const float f = 1e-4f + (float)i * ((15.0f - 1e-4f) / 15.0f);
                    float rev = f * (float)t / (float)L; rev -= floorf(rev); float s, c; sincospif(2.0f * rev, &s, &c); z = (j <= 16) ? c : -s; }
                zs[ti * 64 + j] = z;
            }
            __syncthreads();
            const float fr = A.in[I_FFREQ][l * 64 + j];
            { float a = A.in[I_FB1][l * 64 + j]; const float* w1 = A.in[I_FW1] + l * 33 * 64;
              for (int i = 0; i < 33; ++i) a += zs[ti * 64 + i] * w1[i * 64 + j];
              ha[ti * 64 + j] = sinf(fr * a); }
            __syncthreads();
            { float a = A.in[I_FB2][l * 64 + j]; const float* w2 = A.in[I_FW2] + l * 64 * 64;
              for (int i = 0; i < 64; ++i) a += ha[ti * 64 + i] * w2[i * 64 + j];
              hb[ti * 64 + j] = sinf(fr * a); }
            __syncthreads();
            { float a = A.in[I_FB3][l * 64 + j]; const float* w3 = A.in[I_FW3] + l * 64 * 64;
              for (int i = 0; i < 64; ++i) a += hb[ti * 64 + i] * w3[i * 64 + j];
              H3[((size_t)l * 4352 + tt) * 64 + j] = sinf(fr * a); }
        }
        __syncthreads();
    }
}

__device__ __forceinline__ void ln_stats(const f32x4 (&v)[4], float& mean, float& rstd, float eps) {
    float s = 0.f;
#pragma unroll
    for (int j = 0; j < 4; ++j) s += (v[j].x + v[j].y) + (v[j].z + v[j].w);
    mean = wave_sum(s) * (1.f / 1024.f); float s2 = 0.f;
#pragma unroll
    for (int j = 0; j < 4; ++j) { const f32x4 d = v[j] - mean; s2 += (d.x * d.x + d.y * d.y) + (d.z * d.z + d.w * d.w); }
    rstd = 1.f / sqrtf(wave_sum(s2) * (1.f / 1024.f) + eps);
}
__device__ __forceinline__ void ln_mod_store(const f32x4 (&v)[4], const float* modv, bf16* orow, int lane) {
    float mean, rstd; ln_stats(v, mean, rstd, 1e-6f);
    unsigned long long* o8 = (unsigned long long*)orow + lane;
#pragma unroll
    for (int j = 0; j < 4; ++j) { const f32x4 sh = *((const f32x4*)modv + lane + 64 * j), sc = *((const f32x4*)(modv + 1024) + lane + 64 * j);
        const f32x4 y = (v[j] - mean) * rstd * (1.f + sc) + sh;
        o8[64 * j] = (unsigned long long)pk2(y.x, y.y) | ((unsigned long long)pk2(y.z, y.w) << 32); }
}
__device__ __forceinline__ void row_map(int m, int& islat, int& b, int& t) {
    const int hf = m / HROWS, r = m % HROWS;
    if (r < HLAT) { islat = 1; b = hf * 4 + (r >> 12); t = r & 4095; }
    else { islat = 0; const int rc = r - HLAT; b = hf * 4 + (rc >> 8); t = rc & 255; }
}

__device__ __forceinline__ void phase1(Frame& F, const Args& A) {
    F.refresh();
    const int gw = F.bid * NWAVES + F.wave, NGW = F.G * NWAVES;
    const float* MOD = (const float*)(F.ws + WS_MOD);
    bf16* XN = (bf16*)(F.ws + WS_XN);
    for (int m = gw; m < MTOT; m += NGW) {
        int islat, b, t; row_map(m, islat, b, t);
        const float* src = islat ? A.in[I_X] + ((size_t)b * SEQ + t) * DM : A.in[I_CTX] + ((size_t)b * LCTX + t) * DM;
        const float* modv = MOD + (size_t)(0 * 9 + (islat ? b : 8)) * 3072;
        f32x4 v[4];
#pragma unroll
        for (int j = 0; j < 4; ++j) v[j] = *((const f32x4*)src + F.lane + 64 * j);
        ln_mod_store(v, modv, XN + (size_t)m * DM, F.lane);
    }
    {
        LAS float* hs = (LAS float*)F.lds;
        const float* H3 = (const float*)(F.ws + WS_H3);
        const float min_decay = -3.0701134573253945f, max_decay = -15.350567286626973f;
        for (int it = F.bid; it < 528; it += F.G) {
            int l, g; if (it < 272) { l = 0; g = it; } else { l = 1; g = it - 272; }
            int L, t0, N2; const float* hbase; float* dst;
            if (g < 256) { L = 4096; t0 = g * 16; N2 = 8192; hbase = H3 + ((size_t)l * 4352 + t0) * 64; dst = (float*)(F.ws + WS_KFULL) + (size_t)l * 2 * 512 * 8192; }
            else { L = 256; t0 = (g - 256) * 16; N2 = 512; hbase = H3 + ((size_t)l * 4352 + 4096 + t0) * 64; dst = (float*)(F.ws + WS_KC); }
            __syncthreads();
            hs[F.tid] = hbase[F.tid]; hs[F.tid + 512] = hbase[F.tid + 512];
            __syncthreads();
            const int c = F.tid;
            const float absd = fabsf(min_decay + (float)c * ((max_decay - min_decay) / 511.0f));
            for (int conv = 0; conv < 2; ++conv) {
                const float* wo = A.in[I_FWOUT] + (size_t)l * 64 * 2048 + conv * 1024 + c;
                float af[16], ab[16];
#pragma unroll
                for (int i = 0; i < 16; ++i) { af[i] = 0.f; ab[i] = 0.f; }
                for (int k = 0; k < 64; ++k) { const float wf = wo[(size_t)k * 2048], wb = wo[(size_t)k * 2048 + 512];
#pragma unroll
                    for (int i = 0; i < 16; ++i) { const float h = hs[i * 64 + k]; af[i] += h * wf; ab[i] += h * wb; } }
#pragma unroll
                for (int i = 0; i < 16; ++i) { const float win = __expf(-((float)(t0 + i) / (float)(L - 1)) * absd); af[i] *= win; ab[i] *= win; }
                float* row = dst + (size_t)(conv * 512 + c) * N2;
                if (t0 == 0) { af[0] += ab[0]; row[L] = 0.f; }
#pragma unroll
                for (int q = 0; q < 4; ++q) *(f32x4*)(row + t0 + 4 * q) = (f32x4){af[4 * q], af[4 * q + 1], af[4 * q + 2], af[4 * q + 3]};
#pragma unroll
                for (int i = 0; i < 16; ++i) { const int t = t0 + i; if (t >= 1) row[N2 - t] = ab[i]; }
            }
        }
        __syncthreads();
    }
}

__device__ __forceinline__ int padi(int i) { return i + (i >> 5); }
constexpr int FFT_BUF_ELEMS = 8192 + 256;
__device__ __forceinline__ f32x2 cmul(f32x2 a, f32x2 w) { return (f32x2){a.x * w.x - a.y * w.y, a.x * w.y + a.y * w.x}; }
__device__ __forceinline__ f32x2 cmulc(f32x2 a, f32x2 w) { return (f32x2){a.x * w.x + a.y * w.y, a.y * w.x - a.x * w.y}; }
__device__ constexpr float COS32[16] = {1.0f, 0.98078528040323043f, 0.92387953251128674f, 0.83146961230254524f, 0.70710678118654757f, 0.55557023301960229f, 0.38268343236508984f, 0.19509032201612833f,
                                        0.0f, -0.19509032201612819f, -0.38268343236508973f, -0.55557023301960196f, -0.70710678118654746f, -0.83146961230254535f, -0.92387953251128674f, -0.98078528040323043f};
__device__ constexpr float SIN32[16] = {0.0f, 0.19509032201612825f, 0.38268343236508978f, 0.55557023301960218f, 0.70710678118654746f, 0.83146961230254524f, 0.92387953251128674f, 0.98078528040323043f,
                                        1.0f, 0.98078528040323043f, 0.92387953251128674f, 0.83146961230254546f, 0.70710678118654757f, 0.55557023301960218f, 0.38268343236508989f, 0.19509032201612861f};
__host__ __device__ constexpr int brevk(int q, int k) { int r = 0; for (int i = 0; i < k; ++i) r |= ((q >> i) & 1) << (k - 1 - i); return r; }
template <int R> __device__ __forceinline__ void dif_reg(f32x2 (&x)[R]) {
#pragma unroll
    for (int s = R; s >= 2; s >>= 1) {
#pragma unroll
        for (int blk = 0; blk < R; blk += s) {
#pragma unroll
            for (int p = 0; p < s / 2; ++p) {
                const f32x2 a = x[blk + p], b = x[blk + p + s / 2];
                x[blk + p] = a + b;
                const f32x2 d = a - b;
                const int e = p * (32 / s);
                if (e == 0) x[blk + p + s / 2] = d;
                else if (e == 8) x[blk + p + s / 2] = (f32x2){d.y, -d.x};
                else x[blk + p + s / 2] = (f32x2){d.x * COS32[e] + d.y * SIN32[e], d.y * COS32[e] - d.x * SIN32[e]};
            }
        }
    }
}
template <int R> __device__ __forceinline__ void dit_reg(f32x2 (&x)[R]) {
#pragma unroll
    for (int s = 2; s <= R; s <<= 1) {
#pragma unroll
        for (int blk = 0; blk < R; blk += s) {
#pragma unroll
            for (int p = 0; p < s / 2; ++p) {
                const f32x2 A = x[blk + p], b = x[blk + p + s / 2];
                const int e = p * (32 / s);
                f32x2 B;
                if (e == 0) B = b;
                else if (e == 8) B = (f32x2){-b.y, b.x};
                else B = (f32x2){b.x * COS32[e] - b.y * SIN32[e], b.y * COS32[e] + b.x * SIN32[e]};
                x[blk + p] = A + B; x[blk + p + s / 2] = A - B;
            }
        }
    }
}
template <int K, bool INV> __device__ __forceinline__ void fft_pass(LAS f32x2* buf, const LAS f32x2* tw, int n, int lgst, int tid) {
    constexpr int R = 1 << K;
    const int st = 1 << lgst;
    for (int bf = tid; bf < (8192 >> K); bf += NTHR) {
        const int j = bf & (st - 1), base = (bf >> lgst) * n + j;
        f32x2 x[R];
#pragma unroll
        for (int q = 0; q < R; ++q) x[q] = buf[padi(base + q * st)];
        if (!INV) {
            dif_reg<R>(x);
            if (st > 1) { const f32x2 w1 = tw[j * (8192 / n)]; f32x2 w = w1;
#pragma unroll
                for (int r = 1; r < R; ++r) { x[brevk(r, K)] = cmul(x[brevk(r, K)], w); if (r + 1 < R) w = cmul(w, w1); } }
        } else {
            if (st > 1) { const f32x2 w1 = tw[j * (8192 / n)]; f32x2 w = w1;
#pragma unroll
                for (int r = 1; r < R; ++r) { x[brevk(r, K)] = cmulc(x[brevk(r, K)], w); if (r + 1 < R) w = cmul(w, w1); } }
            dit_reg<R>(x);
        }
#pragma unroll
        for (int q = 0; q < R; ++q) buf[padi(base + q * st)] = x[q];
    }
}
__device__ __forceinline__ void fft_fwd(LAS f32x2* buf, const LAS f32x2* tw, int tid) {
    __syncthreads(); fft_pass<4, false>(buf, tw, 8192, 9, tid);
    __syncthreads(); fft_pass<4, false>(buf, tw, 512, 5, tid);
    __syncthreads(); fft_pass<5, false>(buf, tw, 32, 0, tid);
    __syncthreads();
}
__device__ __forceinline__ void fft_inv(LAS f32x2* buf, const LAS f32x2* tw, int tid) {
    __syncthreads(); fft_pass<5, true>(buf, tw, 32, 0, tid);
    __syncthreads(); fft_pass<4, true>(buf, tw, 512, 5, tid);
    __syncthreads(); fft_pass<4, true>(buf, tw, 8192, 9, tid);
    __syncthreads();
}
__device__ __forceinline__ int brev13(int k) { return (int)(__brev((unsigned)k) >> 19); }
__device__ __forceinline__ void load_tw(Frame& F, LAS f32x2* tw) {
    const f32x2* g = (const f32x2*)(F.ws + WS_TW);
    for (int j = F.tid; j < 4096; j += NTHR) tw[j] = g[j];
}

__device__ __forceinline__ void phase1b(Frame& F) {
    F.refresh();
    LAS f32x2* buf = (LAS f32x2*)F.lds; LAS f32x2* tw = buf + FFT_BUF_ELEMS;
    load_tw(F, tw);
    for (int it = F.bid; it < 1024; it += F.G) {
        const int l = it >> 9, conv = (it >> 8) & 1, pair = it & 255;
        const float* ka = (const float*)(F.ws + WS_KFULL) + ((size_t)(l * 2 + conv) * 512 + 2 * pair) * 8192; const float* kb = ka + 8192;
        __syncthreads();
        for (int i = F.tid; i < 8192; i += NTHR) buf[padi(i)] = (f32x2){ka[i], kb[i]};
        fft_fwd(buf, tw, F.tid);
        f32x4* sp = (f32x4*)(F.ws + WS_SPEC) + (size_t)it * SPEC_LD;
        const float sc = 1.0f / (4.0f * 8192.0f);
        for (int k = F.tid; k <= 4096; k += NTHR) {
            const int kn = (8192 - k) & 8191; const f32x2 zk = buf[padi(brev13(k))], zn = buf[padi(brev13(kn))];
            const f32x2 A = (f32x2){zk.x + zn.x, zk.y - zn.y}, D = (f32x2){zk.x - zn.x, zk.y + zn.y};
            const f32x2 Bk = (f32x2){D.y, -D.x};
            sp[k] = (f32x4){(A.x + Bk.x) * sc, (A.y + Bk.y) * sc, (A.x - Bk.x) * sc, (A.y - Bk.y) * sc};
        }
    }
    __syncthreads();
}

__device__ __forceinline__ float conv3(const bf16* row, int t, int Ls, float w0, float w1, float w2, float b) {
    const float u0 = t > 0 ? bf2f(row[t - 1]) : 0.f, u1 = bf2f(row[t]), u2 = t < Ls - 1 ? bf2f(row[t + 1]) : 0.f;
    return w0 * u0 + w1 * u1 + w2 * u2 + b;
}
__device__ __forceinline__ void pointwise_spec(LAS f32x2* buf, const f32x4* sp, int tid) {
    for (int k = tid; k <= 4096; k += NTHR) {
        const int kn = (8192 - k) & 8191, p = padi(brev13(k)), pn = padi(brev13(kn));
        const f32x4 s = sp[k]; const f32x2 P = (f32x2){s.x, s.y}, M = (f32x2){s.z, s.w};
        const f32x2 zk = buf[p], zn = buf[pn];
        const f32x2 znc = (f32x2){zn.x, -zn.y}, zkc = (f32x2){zk.x, -zk.y};
        const f32x2 yk = cmul(zk, P) + cmul(znc, M);
        const f32x2 yn = cmulc(zn, P) + cmulc(zkc, M);
        buf[p] = yk; if (pn != p) buf[pn] = yn;
    }
}
__device__ __forceinline__ void hyena_tile(Frame& F, const Args& A, int l, int hf, int bl, int pair, LAS f32x2* buf, const LAS f32x2* tw) {
    F.refresh();
    const bf16* U = (const bf16*)(F.ws + WS_UHY) + (size_t)bl * SEQ;
    const int c0 = 2 * pair;
    const float* cw = A.in[I_HCW] + (size_t)l * 3 * 1536; const float* cb = A.in[I_HCB] + (size_t)l * 1536;
    float w[3][2][3], bb[3][2];
#pragma unroll
    for (int s = 0; s < 3; ++s)
#pragma unroll
        for (int ch = 0; ch < 2; ++ch) { const int col = s * 512 + c0 + ch; bb[s][ch] = cb[col];
#pragma unroll
            for (int j = 0; j < 3; ++j) w[s][ch][j] = cw[j * 1536 + col]; }
    const float hb0a = A.in[I_HBIAS][(l * 2 + 0) * 512 + c0], hb0b = A.in[I_HBIAS][(l * 2 + 0) * 512 + c0 + 1];
    const float hb1a = A.in[I_HBIAS][(l * 2 + 1) * 512 + c0], hb1b = A.in[I_HBIAS][(l * 2 + 1) * 512 + c0 + 1];
    const bf16* rv0 = U + (size_t)(c0) * HROWS; const bf16* rv1 = rv0 + HROWS;
    const bf16* r10 = U + (size_t)(512 + c0) * HROWS; const bf16* r11 = r10 + HROWS;
    const bf16* r20 = U + (size_t)(1024 + c0) * HROWS; const bf16* r21 = r20 + HROWS;
    const bf16* rg0 = U + (size_t)(1536 + c0) * HROWS; const bf16* rg1 = rg0 + HROWS;
    const f32x4* sp0 = (const f32x4*)(F.ws + WS_SPEC) + (size_t)((l * 2 + 0) * 256 + pair) * SPEC_LD;
    const f32x4* sp1 = (const f32x4*)(F.ws + WS_SPEC) + (size_t)((l * 2 + 1) * 256 + pair) * SPEC_LD;
    __syncthreads();
#pragma unroll
    for (int i = 0; i < 8; ++i) { const int t = F.tid + NTHR * i;
        const float va = conv3(rv0, t, SEQ, w[0][0][0], w[0][0][1], w[0][0][2], bb[0][0]), vb = conv3(rv1, t, SEQ, w[0][1][0], w[0][1][1], w[0][1][2], bb[0][1]);
        buf[padi(t)] = (f32x2){va, vb}; buf[padi(t + 4096)] = (f32x2){0.f, 0.f}; }
    fft_fwd(buf, tw, F.tid); pointwise_spec(buf, sp0, F.tid); fft_inv(buf, tw, F.tid);
    f32x2 y1r[8];
#pragma unroll
    for (int i = 0; i < 8; ++i) { const int t = F.tid + NTHR * i;
        const f32x2 cv = buf[padi(t)];
        const float va = conv3(rv0, t, SEQ, w[0][0][0], w[0][0][1], w[0][0][2], bb[0][0]), vb = conv3(rv1, t, SEQ, w[0][1][0], w[0][1][1], w[0][1][2], bb[0][1]);
        const float xa = conv3(r10, t, SEQ, w[1][0][0], w[1][0][1], w[1][0][2], bb[1][0]), xb = conv3(r11, t, SEQ, w[1][1][0], w[1][1][1], w[1][1][2], bb[1][1]);
        y1r[i] = (f32x2){xa * (cv.x + va * hb0a), xb * (cv.y + vb * hb0b)};
        buf[padi(t)] = y1r[i]; buf[padi(t + 4096)] = (f32x2){0.f, 0.f}; }
    fft_fwd(buf, tw, F.tid); pointwise_spec(buf, sp1, F.tid); fft_inv(buf, tw, F.tid);
    bf16* Y = (bf16*)(F.ws + WS_Y) + ((size_t)hf * HROWS + (size_t)bl * SEQ) * Y_LD + c0;
#pragma unroll
    for (int i = 0; i < 8; ++i) { const int t = F.tid + NTHR * i;
        const f32x2 cv = buf[padi(t)];
        const float xa = conv3(r20, t, SEQ, w[2][0][0], w[2][0][1], w[2][0][2], bb[2][0]), xb = conv3(r21, t, SEQ, w[2][1][0], w[2][1][1], w[2][1][2], bb[2][1]);
        const float ga = bf2f(rg0[t]), gb = bf2f(rg1[t]);
        const float oa = xa * (cv.x + y1r[i].x * hb1a) * siluf(ga), ob = xb * (cv.y + y1r[i].y * hb1b) * siluf(gb);
        *(unsigned*)(Y + (size_t)t * Y_LD) = pk2(oa, ob); }
}
__device__ __forceinline__ void hyena_ctx_tile(Frame& F, const Args& A, int hf, int bl, int pair, LAS float* ks  , LAS float* sig  ) {
    F.refresh();
    const int l = 0;
    const bf16* U = (const bf16*)(F.ws + WS_UHY) + HLAT + (size_t)bl * LCTX;
    const int ch = F.tid >> 8, t = F.tid & 255, c = 2 * pair + ch;
    const float* cw = A.in[I_HCW] + (size_t)l * 3 * 1536; const float* cb = A.in[I_HCB] + (size_t)l * 1536;
    const float* KC = (const float*)(F.ws + WS_KC);
    __syncthreads();
    for (int idx = F.tid; idx < 2048; idx += NTHR) { const int conv = idx >> 10, chh = (idx >> 9) & 1, i = idx & 511; ks[idx] = KC[(size_t)(conv * 512 + 2 * pair + chh) * 512 + i]; }
    const float vc = conv3(U + (size_t)c * HROWS, t, LCTX, cw[c], cw[1536 + c], cw[3072 + c], cb[c]);
    sig[ch * 256 + t] = vc;
    __syncthreads();
    float acc = 0.f;
    for (int s = 0; s < 256; ++s) acc += ks[(0 * 2 + ch) * 512 + ((t - s) & 511)] * sig[ch * 256 + s];
    const float x1 = conv3(U + (size_t)(512 + c) * HROWS, t, LCTX, cw[512 + c], cw[1536 + 512 + c], cw[3072 + 512 + c], cb[512 + c]);
    const float y1 = x1 * (acc + vc * A.in[I_HBIAS][(l * 2 + 0) * 512 + c]);
    __syncthreads();
    sig[ch * 256 + t] = y1;
    __syncthreads();
    float acc2 = 0.f;
    for (int s = 0; s < 256; ++s) acc2 += ks[(1 * 2 + ch) * 512 + ((t - s) & 511)] * sig[ch * 256 + s];
    const float x2 = conv3(U + (size_t)(1024 + c) * HROWS, t, LCTX, cw[1024 + c], cw[1536 + 1024 + c], cw[3072 + 1024 + c], cb[1024 + c]);
    const float g = bf2f(U[(size_t)(1536 + c) * HROWS + t]);
    const float o = x2 * (acc2 + y1 * A.in[I_HBIAS][(l * 2 + 1) * 512 + c]) * siluf(g);
    bf16* Y = (bf16*)(F.ws + WS_Y) + ((size_t)hf * HROWS + HLAT + (size_t)bl * LCTX + t) * Y_LD + c;
    *Y = (bf16)f2bf(o);
}
__device__ __forceinline__ float softplusf(float x) { return x > 20.f ? x : log1pf(__expf(x)); }
__device__ __forceinline__ void ssd_chain(Frame& F, const Args& A, int l, int chain) {
    F.refresh();
    const int bl = chain >> 4, h = (chain >> 1) & 7, dir = chain & 1, g = h >> 2;
    LAS float* xs = (LAS float*)F.lds;
    LAS float* Bs = xs + 4096;
    LAS float* Cs = Bs + 8192;
    LAS float* decs = Cs + 8192;
    LAS float* dts = decs + 64;
    LAS float* ybuf = dts + 64;
    const int p = F.tid >> 3, ns = F.tid & 7, n0 = ns * 16;
    float s[16];
#pragma unroll
    for (int i = 0; i < 16; ++i) s[i] = 0.f;
    const float a = -__expf(A.in[I_ALOG][(l * 2 + dir) * 8 + h]), dtb = A.in[I_DTB][(l * 2 + dir) * 8 + h];
    const bf16* UR = (const bf16*)(F.ws + WS_UR);
    const float* cw = A.in[I_SCW] + (size_t)l * 3 * 1024; const float* cb = A.in[I_SCB] + (size_t)l * 1024;
    float* YX = (float*)(F.ws + (dir ? WS_YB : WS_YF));
    for (int seg = 0; seg < 2; ++seg) {
        const int Ls = seg == 0 ? LCTX : SEQ, rowbase = seg == 0 ? HLAT + bl * LCTX : bl * SEQ, nch = Ls / 64;
        for (int ci = 0; ci < nch; ++ci) {
            const int t0 = (dir == 0 ? ci : nch - 1 - ci) * 64;
            __syncthreads();
            for (int e = F.tid; e < 64 * 320; e += NTHR) {
                const int tt = e / 320, cc = e - tt * 320, t = t0 + tt;
                const int col = cc < 64 ? h * 64 + cc : (cc < 192 ? 512 + g * 128 + (cc - 64) : 768 + g * 128 + (cc - 192));
                const bf16* up = UR + (size_t)(rowbase + t) * UR_LD + col;
                const float u0 = t > 0 ? bf2f(up[-UR_LD]) : 0.f, u1 = bf2f(up[0]), u2 = t < Ls - 1 ? bf2f(up[UR_LD]) : 0.f;
                const float v = siluf(cw[col] * u0 + cw[1024 + col] * u1 + cw[2048 + col] * u2 + cb[col]);
                if (cc < 64) xs[tt * 64 + cc] = v; else if (cc < 192) Bs[tt * 128 + cc - 64] = v; else Cs[tt * 128 + cc - 192] = v;
            }
            if (F.tid < 64) { const float dtv = softplusf(bf2f(UR[(size_t)(rowbase + t0 + F.tid) * UR_LD + UR_DT + dir * 8 + h]) + dtb); dts[F.tid] = dtv; decs[F.tid] = __expf(dtv * a); }
            __syncthreads();
            for (int k = 0; k < 64; ++k) {
                const int tt = dir == 0 ? k : 63 - k;
                const float dec = decs[tt], xd = xs[tt * 64 + p] * dts[tt];
                float acc = 0.f;
#pragma unroll
                for (int q = 0; q < 4; ++q) { const f32x4 b4 = *(const LAS f32x4*)(Bs + tt * 128 + n0 + 4 * q), c4 = *(const LAS f32x4*)(Cs + tt * 128 + n0 + 4 * q);
#pragma unroll
                    for (int e = 0; e < 4; ++e) { s[4 * q + e] = s[4 * q + e] * dec + xd * b4[e]; acc += s[4 * q + e] * c4[e]; } }
                acc += __shfl_xor(acc, 1); acc += __shfl_xor(acc, 2); acc += __shfl_xor(acc, 4);
                if (ns == 0) ybuf[tt * 64 + p] = acc;
            }
            __syncthreads();
            for (int e = F.tid; e < 4096; e += NTHR) YX[(size_t)(rowbase + t0 + (e >> 6)) * 512 + h * 64 + (e & 63)] = ybuf[e];
        }
    }
    __syncthreads();
}
__device__ __forceinline__ void ssd_finish(Frame& F, const Args& A, int l, int hf, int nrows) {
    F.refresh();
    const int gw = F.bid * NWAVES + F.wave, NGW = F.G * NWAVES;
    const bf16* UR = (const bf16*)(F.ws + WS_UR);
    const float* YF = (const float*)(F.ws + WS_YF); const float* YB = (const float*)(F.ws + WS_YB);
    const float* cw = A.in[I_SCW] + (size_t)l * 3 * 1024; const float* cb = A.in[I_SCB] + (size_t)l * 1024;
    const int c = F.lane * 8;
    const float D = A.in[I_SD][l * 8 + (F.lane >> 3)];
    for (int r = gw; r < nrows; r += NGW) {
        int t, Ls; if (r < HLAT) { t = r & 4095; Ls = SEQ; } else { t = (r - HLAT) & 255; Ls = LCTX; }
        const bf16* up = UR + (size_t)r * UR_LD + c;
        const v4u zero4 = (v4u){0u, 0u, 0u, 0u};
        const v4u u0 = t > 0 ? *(const v4u*)(up - UR_LD) : zero4, u1 = *(const v4u*)up, u2 = t < Ls - 1 ? *(const v4u*)(up + UR_LD) : zero4;
        const v4u zz = *(const v4u*)(UR + (size_t)r * UR_LD + UR_Z + c);
        float y[8]; float ss = 0.f;
#pragma unroll
        for (int q = 0; q < 4; ++q) {
            const f32x2 a0 = {bflo(u0[q]), bfhi(u0[q])}, a1 = {bflo(u1[q]), bfhi(u1[q])}, a2 = {bflo(u2[q]), bfhi(u2[q])}, z2 = {bflo(zz[q]), bfhi(zz[q])};
#pragma unroll
            for (int e = 0; e < 2; ++e) { const int cc = c + 2 * q + e;
                const float xv = siluf(cw[cc] * a0[e] + cw[1024 + cc] * a1[e] + cw[2048 + cc] * a2[e] + cb[cc]);
                const float yy = (YF[(size_t)r * 512 + cc] + YB[(size_t)r * 512 + cc] + xv * D) * siluf(z2[e]);
                y[2 * q + e] = yy; ss += yy * yy; }
        }
#pragma unroll
        for (int o = 1; o < 32; o <<= 1) ss += __shfl_xor(ss, o);
        const float rs = 1.f / sqrtf(ss * (1.f / 256.f) + 1e-5f);
        const float* nw = A.in[I_SNW] + l * 512 + c;
        v4u o4;
        o4.x = pk2(y[0] * rs * nw[0], y[1] * rs * nw[1]); o4.y = pk2(y[2] * rs * nw[2], y[3] * rs * nw[3]);
        o4.z = pk2(y[4] * rs * nw[4], y[5] * rs * nw[5]); o4.w = pk2(y[6] * rs * nw[6], y[7] * rs * nw[7]);
        *(v4u*)((bf16*)(F.ws + WS_Y) + ((size_t)hf * HROWS + r) * Y_LD + 512 + c) = o4;
    }
}
__device__ __forceinline__ void attn_tile(Frame& F, const Args& A, int l, int hf, int bl, int kvh, int qb, bool isctx, LAS float* Ks, LAS float* Vs, const LAS f32x2* rope) {
    F.refresh();
    const bf16* UR = (const bf16*)(F.ws + WS_UR);
    const int g = F.tid >> 7, qi = F.tid & 127, hq = kvh * 4 + g, t = qb * 128 + qi;
    const int qrow = isctx ? HLAT + bl * LCTX + t : bl * SEQ + t;
    float q[64];
    { const bf16* qp = UR + (size_t)qrow * UR_LD + UR_Q + hq * 64;
#pragma unroll
      for (int v = 0; v < 8; ++v) { const v4u w = *(const v4u*)(qp + 8 * v);
#pragma unroll
          for (int e = 0; e < 4; ++e) { q[8 * v + 2 * e] = bflo(w[e]); q[8 * v + 2 * e + 1] = bfhi(w[e]); } }
      if (!isctx) { const int rp = t >> 6, cp = t & 63;
#pragma unroll
          for (int i = 0; i < 16; ++i) { const f32x2 r = rope[rp * 16 + i], c2 = rope[cp * 16 + i];
              const float a = q[i], b = q[i + 16]; q[i] = a * r.x - b * r.y; q[i + 16] = a * r.y + b * r.x;
              const float a2 = q[32 + i], b2 = q[48 + i]; q[32 + i] = a2 * c2.x - b2 * c2.y; q[48 + i] = a2 * c2.y + b2 * c2.x; } }
#pragma unroll
      for (int d = 0; d < 64; ++d) q[d] *= 0.125f; }
    float m = A.in[I_SINK][l * 8 + hq], lsum = 1.f;
    float o[64];
#pragma unroll
    for (int d = 0; d < 64; ++d) o[d] = 0.f;
    for (int kt = isctx ? 3 : 0; kt < 5; ++kt) {
        const int jb = qb - 1 + kt;
        if (kt < 3 && (jb < 0 || jb >= SEQ / 128)) continue;
        const int krow0 = kt < 3 ? bl * SEQ + jb * 128 : HLAT + bl * LCTX + (kt - 3) * 128;
        __syncthreads();
        { const int row = F.tid >> 2, hs = (F.tid >> 1) & 1, sub = F.tid & 1, dlo = hs * 32 + sub * 8;
          const bf16* kp = UR + (size_t)(krow0 + row) * UR_LD + UR_K + kvh * 64 + dlo; const bf16* vp = kp + (UR_V - UR_K);
          const v4u k0 = *(const v4u*)kp, k1 = *(const v4u*)(kp + 16), v0 = *(const v4u*)vp, v1 = *(const v4u*)(vp + 16);
          float ka[8], kb[8];
#pragma unroll
          for (int e = 0; e < 4; ++e) { ka[2 * e] = bflo(k0[e]); ka[2 * e + 1] = bfhi(k0[e]); kb[2 * e] = bflo(k1[e]); kb[2 * e + 1] = bfhi(k1[e]); }
          if (kt < 3) { const int j = jb * 128 + row, pos = hs == 0 ? (j >> 6) : (j & 63);
#pragma unroll
              for (int e = 0; e < 8; ++e) { const f32x2 r = rope[pos * 16 + sub * 8 + e]; const float a = ka[e], b = kb[e]; ka[e] = a * r.x - b * r.y; kb[e] = a * r.y + b * r.x; } }
#pragma unroll
          for (int e = 0; e < 8; ++e) { Ks[row * 64 + dlo + e] = ka[e]; Ks[row * 64 + dlo + 16 + e] = kb[e]; }
#pragma unroll
          for (int e = 0; e < 4; ++e) { Vs[row * 64 + dlo + 2 * e] = bflo(v0[e]); Vs[row * 64 + dlo + 2 * e + 1] = bfhi(v0[e]); Vs[row * 64 + dlo + 16 + 2 * e] = bflo(v1[e]); Vs[row * 64 + dlo + 16 + 2 * e + 1] = bfhi(v1[e]); } }
        __syncthreads();
#pragma unroll 1
        for (int key = 0; key < 128; ++key) {
            float a = 0.f;
#pragma unroll
            for (int v = 0; v < 16; ++v) { const f32x4 k4 = *(const LAS f32x4*)(Ks + key * 64 + 4 * v); a += q[4 * v] * k4.x + q[4 * v + 1] * k4.y + q[4 * v + 2] * k4.z + q[4 * v + 3] * k4.w; }
            if (kt < 3) { const int j = jb * 128 + key, dlt = t - j; if (dlt > 128 || dlt < -128) a = -INFINITY; }
            if (__any(a > m)) { const float mn = fmaxf(m, a), alpha = __expf(m - mn); m = mn; lsum *= alpha;
#pragma unroll
                for (int d = 0; d < 64; ++d) o[d] *= alpha; }
            const float pz = __expf(a - m); lsum += pz;
#pragma unroll
            for (int v = 0; v < 16; ++v) { const f32x4 v4 = *(const LAS f32x4*)(Vs + key * 64 + 4 * v); o[4 * v] += pz * v4.x; o[4 * v + 1] += pz * v4.y; o[4 * v + 2] += pz * v4.z; o[4 * v + 3] += pz * v4.w; }
        }
    }
    const float inv = 1.f / lsum;
    const bf16* zp = UR + (size_t)qrow * UR_LD + UR_ZA + hq * 64;
    bf16* yp = (bf16*)(F.ws + WS_Y) + ((size_t)hf * HROWS + qrow) * Y_LD + 1024 + hq * 64;
#pragma unroll
    for (int v = 0; v < 8; ++v) { const v4u zw = *(const v4u*)(zp + 8 * v); v4u ow;
#pragma unroll
        for (int e = 0; e < 4; ++e) ow[e] = pk2(o[8 * v + 2 * e] * inv * siluf(bflo(zw[e])), o[8 * v + 2 * e + 1] * inv * siluf(bfhi(zw[e])));
        *(v4u*)(yp + 8 * v) = ow; }
}
__device__ __forceinline__ void phase3(Frame& F, const Args& A, int l, int hf, unsigned* ctr) {
    F.refresh();
    if (F.bid < 64) ssd_chain(F, A, l, F.bid);
    LAS f32x2* buf = (LAS f32x2*)F.lds; LAS f32x2* tw = buf + FFT_BUF_ELEMS;
    LAS float* cks = (LAS float*)(F.lds + 100352); LAS float* csig = cks + 2048;
    LAS float* Ks = (LAS float*)F.lds; LAS float* Vs = Ks + 8192; LAS f32x2* rope = (LAS f32x2*)(Vs + 8192);
    const int n_hy = 1024, n_hc = (l == 0) ? 1024 : 0, n_at = 256, n_ac = (l == 0) ? 16 : 0;
    const int total = n_hy + n_hc + n_at + n_ac;
    bool tw_loaded = false, rope_loaded = false;
    for (;;) {
        int tile = next_tile(F, ctr);
        if (tile >= total) break;
        if (tile < n_hy) { if (!tw_loaded) { load_tw(F, tw); tw_loaded = true; } hyena_tile(F, A, l, hf, tile & 3, tile >> 2, buf, tw); continue; }
        tile -= n_hy;
        if (tile < n_hc) { hyena_ctx_tile(F, A, hf, tile & 3, tile >> 2, cks, csig); continue; }
        tile -= n_hc;
        if (!rope_loaded) { __syncthreads(); const f32x2* gr = (const f32x2*)(F.ws + WS_ROPE); for (int j = F.tid; j < 1024; j += NTHR) rope[j] = gr[j]; rope_loaded = true; __syncthreads(); }
        if (tile < n_at) { attn_tile(F, A, l, hf, tile >> 6, (tile >> 5) & 1, tile & 31, false, Ks, Vs, rope); continue; }
        tile -= n_at;
        attn_tile(F, A, l, hf, tile >> 2, (tile >> 1) & 1, tile & 1, true, Ks, Vs, rope);
    }
    __syncthreads();
}

__device__ __forceinline__ void phase5(Frame& F, const Args& A, int l) {
    F.refresh();
    const int gw = F.bid * NWAVES + F.wave, NGW = F.G * NWAVES;
    const float* T = (const float*)(F.ws + WS_T);
    const float* MOD = (const float*)(F.ws + WS_MOD);
    const float* lg = A.in[I_LNG] + l * 1024; const float* lb = A.in[I_LNB] + l * 1024;
    for (int m = gw; m < MTOT; m += NGW) {
        int islat, b, t; row_map(m, islat, b, t);
        if (l == 1 && !islat) continue;
        f32x4 v[4];
#pragma unroll
        for (int j = 0; j < 4; ++j) v[j] = *((const f32x4*)(T + (size_t)m * DM) + F.lane + 64 * j);
        float mean, rstd; ln_stats(v, mean, rstd, 1e-6f);
#pragma unroll
        for (int j = 0; j < 4; ++j) v[j] = (v[j] - mean) * rstd * *((const f32x4*)lg + F.lane + 64 * j) + *((const f32x4*)lb + F.lane + 64 * j);
        if (islat) { f32x4* o = (f32x4*)(F.out + ((size_t)b * SEQ + t) * DM) + F.lane;
#pragma unroll
            for (int j = 0; j < 4; ++j) o[64 * j] = v[j]; }
        if (l == 0) ln_mod_store(v, MOD + (size_t)(1 * 9 + (islat ? b : 8)) * 3072, (bf16*)(F.ws + WS_XN) + (size_t)m * DM, F.lane);
    }
}

__global__ void __launch_bounds__(NTHR, 2) fwd_megakernel(Args args) {
    extern __shared__ __attribute__((aligned(16))) unsigned char lds_raw[];
    Frame F;
    F.lds = (LAS unsigned char*)lds_raw;
    F.tid = threadIdx.x; F.lane = F.tid & 63; F.wave = __builtin_amdgcn_readfirstlane(F.tid >> 6);
    F.bid = blockIdx.x; F.G = gridDim.x; F.out = args.out; F.ws = args.ws;
    for (int u = F.tid; u < (LDS_BYTES - LDSCTL_OFF) / 4; u += NTHR) ((LAS unsigned*)(F.lds + LDSCTL_OFF))[u] = 0u;
    __syncthreads();
    unsigned* ctl = (unsigned*)(F.ws + WS_CTL);
    XcdBarrier bar = xcd_barrier_post(ctl + CW_BAR, (volatile LAS unsigned*)(F.lds + LDSCTL_OFF));
#define GRID_BAR() xcd_barrier(bar)
    phase0(F, args); GRID_BAR();
    phase1(F, args); GRID_BAR();
    phase1b(F); GRID_BAR();
#pragma unroll
    for (int l = 0; l < 2; ++l) {
#pragma unroll
        for (int hf = 0; hf < 2; ++hf) {
            {
                const pg8::bf16_t* XNh = (const pg8::bf16_t*)(F.ws + WS_XN) + (size_t)hf * HROWS * DM;
                { pg8::Gemm g{(const pg8::bf16_t*)(F.ws + WS_WHY) + (size_t)l * 2048 * 1024, XNh, 2048, HROWS, DM}; pg8::StaticOrder S; S.init(2048, HROWS, F.G, F.bid);
                  pg8::EpiBf16 E{(pg8::bf16_t*)(F.ws + WS_UHY), HROWS};
                  pg8::gemm_phase<pg8::EpiBf16, pg8::StaticOrder, true, true>(F.lds, g, S, E); }
                { pg8::Gemm g{XNh, (const pg8::bf16_t*)(F.ws + WS_WR) + (size_t)l * 3072 * 1024, HROWS, UR_LD, DM}; pg8::StaticOrder S; S.init(HROWS, UR_LD, F.G, F.bid);
                  pg8::EpiBf16 E{(pg8::bf16_t*)(F.ws + WS_UR), UR_LD};
                  pg8::gemm_phase<pg8::EpiBf16, pg8::StaticOrder, true, true>(F.lds, g, S, E); }
            }
            GRID_BAR();
            phase3(F, args, l, hf, ctl + CW_CTR + 64 * (l * 2 + hf)); GRID_BAR();
            ssd_finish(F, args, l, hf, l == 0 ? HROWS : HLAT); GRID_BAR();
        }
        {
            pg8::Gemm g{(const pg8::bf16_t*)(F.ws + WS_Y), (const pg8::bf16_t*)(F.ws + WS_WO) + (size_t)l * 1024 * 1536, MTOT, DM, 1536};
            pg8::EpiRes E{l == 0 ? args.in[I_X] : F.out, args.in[I_CTX], (const float*)(F.ws + WS_MOD), (float*)(F.ws + WS_T), l};
            if (l == 0) { pg8::StaticOrder S; S.init(MTOT, DM, F.G, F.bid); pg8::gemm_phase<pg8::EpiRes, pg8::StaticOrder, true, true>(F.lds, g, S, E); }
            else { pg8::OrderLat S; S.S.init(2 * HLAT, DM, F.G, F.bid); pg8::gemm_phase<pg8::EpiRes, pg8::OrderLat, true, true>(F.lds, g, S, E); }
        }
        GRID_BAR();
        phase5(F, args, l);
        if (l == 0) GRID_BAR();
    }
}

extern "C" void kernel_launch(void* const* d_in, const int* in_sizes, int n_in, void* d_out, int out_size, void* d_ws, size_t ws_size, hipStream_t stream) {
    static int grid = 0;
    if (grid == 0) {
        if (n_in != 28 || out_size != NBATCH * SEQ * DM || ws_size < WS_END) { fprintf(stderr, "kernel_launch: unexpected problem (n_in %d, out %d, ws %zu); nothing launched\n", n_in, out_size, ws_size); grid = -1; return; }
        int dev = 0, cus = 0, per_cu = 0;
        if (hipGetDevice(&dev) != hipSuccess || hipDeviceGetAttribute(&cus, hipDeviceAttributeMultiprocessorCount, dev) != hipSuccess) { grid = -1; return; }
        if (hipFuncSetAttribute((const void*)fwd_megakernel, hipFuncAttributeMaxDynamicSharedMemorySize, LDS_BYTES) != hipSuccess) { fprintf(stderr, "kernel_launch: hipFuncSetAttribute failed\n"); grid = -1; return; }
        if (hipOccupancyMaxActiveBlocksPerMultiprocessor(&per_cu, (const void*)fwd_megakernel, NTHR, LDS_BYTES) != hipSuccess || per_cu < 1) { fprintf(stderr, "kernel_launch: occupancy query says %d blocks per CU\n", per_cu); grid = -1; return; }
        (void)hipGetLastError();
        grid = cus;
    }
    if (grid < 0) return;
    (void)hipMemsetAsync((char*)d_ws + WS_CTL, 0, CTL_ZERO_BYTES, stream);
    Args a{};
    for (int i = 0; i < 28; ++i) a.in[i] = (const float*)d_in[i];
    a.out = (float*)d_out; a.ws = (unsigned char*)d_ws; a.ph_lo = 0; a.ph_hi = 0;
    void* kargs[] = {&a};
    hipError_t e = hipLaunchCooperativeKernel((const void*)fwd_megakernel, dim3(grid), dim3(NTHR), kargs, LDS_BYTES, stream);
    if (e != hipSuccess) fprintf(stderr, "kernel_launch: cooperative launch failed: %s (grid %d)\n", hipGetErrorString(e), grid);
}
```

```cpp
#include <hip/hip_runtime.h>
#include <cstdio>
#include <cstdint>
namespace pg8 {
#define PG8_LAS __attribute__((address_space(3)))
typedef unsigned short bf16_t;
typedef short bf16x8 __attribute__((ext_vector_type(8)));
typedef float f32x4 __attribute__((ext_vector_type(4)));
typedef unsigned u32x4 __attribute__((ext_vector_type(4)));
constexpr int BM = 256, BK = 64, HALF = 128, HTB = HALF * BK * 2  , STAGE_BYTES = 8 * HTB, NXCD = 8, WGM = 8;

__host__ __device__ __forceinline__ int lds_byte(int r, int c) { const int st = (r >> 4) * 2 + (c >> 5), rr = r & 15, cc = c & 31, ob = rr * 64 + cc * 2; return st * 1024 + (ob ^ (((ob >> 9) & 1) << 5)); }
__host__ __device__ __forceinline__ void stage_rc(int b, int& R, int& C) { const int st = b / 1024, sb = b % 1024, swz = sb ^ (((sb >> 9) & 1) << 5); R = (st >> 1) * 16 + swz / 64; C = (st & 1) * 32 + (swz % 64) / 2; }
__host__ __device__ __forceinline__ int perm32(int rho) { const int n = rho >> 4, i = rho & 15; return 8 * (i >> 2) + 4 * n + (i & 3); }

struct Unit { int pm, pn; };
struct Gemm { const bf16_t* A; const bf16_t* Bt; int M, N, K; };

struct StaticOrder {
    int nM, nN, nwg, G, c;
    __host__ __device__ void init(int M, int N, int G_, int c_) { nM = M / BM; nN = N / BM; nwg = nM * nN; G = G_; c = c_; }
    __host__ __device__ bool next(int i, Unit& u) const {
        const long L = (long)i * G + c; if (L >= nwg) return false;
        int wgid = (int)L; { const int q = nwg / NXCD, r = nwg % NXCD, xcd = wgid % NXCD, off = wgid / NXCD; wgid = (xcd < r ? xcd * (q + 1) : r * (q + 1) + (xcd - r) * q) + off; }
        const int nig = WGM * nN, gid = wgid / nig, fm = gid * WGM, gsz = (nM - fm) < WGM ? (nM - fm) : WGM;
        u.pm = fm + ((wgid % nig) % gsz); u.pn = (wgid % nig) / gsz; return true;
    }
    __device__ __forceinline__ void a_ready(const Unit&) const {}
    __device__ __forceinline__ void done(const Unit&) const {}
};

__device__ __forceinline__ unsigned cvt_pk_bf16(float lo, float hi) { unsigned r; asm volatile("v_cvt_pk_bf16_f32 %0, %1, %2" : "=v"(r) : "v"(lo), "v"(hi)); return r; }
struct EpiBf16 {
    static constexpr bool PERM = true, AFTER_DRAIN = false;
    bf16_t* O; int ldc;
    __device__ __forceinline__ void operator()(const f32x4 (&acc)[2][2][4][2], const Unit& u, int wr, int wc, int fr, int fq) const {
        asm volatile("" : "+v"(fr), "+v"(fq));
        const int row0 = u.pm * BM + wr * 64 + fr; const int col0 = u.pn * BM + wc * 32 + 8 * fq;
#pragma unroll
        for (int ai = 0; ai < 2; ++ai)
#pragma unroll
            for (int m = 0; m < 4; ++m) { bf16_t* rowp = O + (size_t)(row0 + ai * HALF + m * 16) * ldc + col0;
#pragma unroll
                for (int bj = 0; bj < 2; ++bj) { const f32x4 v0 = acc[ai][bj][m][0], v1 = acc[ai][bj][m][1];
                    u32x4 w; w.x = cvt_pk_bf16(v0[0], v0[1]); w.y = cvt_pk_bf16(v0[2], v0[3]); w.z = cvt_pk_bf16(v1[0], v1[1]); w.w = cvt_pk_bf16(v1[2], v1[3]);
                    *(u32x4*)(rowp + bj * HALF) = w; } }
    }
};
struct EpiRes {
    static constexpr bool PERM = false, AFTER_DRAIN = false;
    const float* xlat; const float* xctx; const float* mod; float* T; int layer;
    __device__ __forceinline__ void operator()(const f32x4 (&acc)[2][2][4][2], const Unit& u, int wr, int wc, int fr, int fq) const {
        asm volatile("" : "+v"(fr), "+v"(fq));
        const int pm = u.pm, hf = pm / 68, pr = pm % 68;
        const float* src; const float* gv;
        if (pr < 64) { const int b = hf * 4 + (pr >> 4); src = xlat + ((size_t)b * 4096 + (size_t)(pr & 15) * 256) * 1024; gv = mod + (size_t)(layer * 9 + b) * 3072 + 2048; }
        else { const int b = hf * 4 + (pr - 64); src = xctx + (size_t)b * 256 * 1024; gv = mod + (size_t)(layer * 9 + 8) * 3072 + 2048; }
        const int col0 = u.pn * BM + wc * 32 + 4 * fq;
        const float alpha = 1.41421356237f;
#pragma unroll
        for (int bj = 0; bj < 2; ++bj)
#pragma unroll
            for (int n = 0; n < 2; ++n) { const int col = col0 + bj * HALF + n * 16; const f32x4 g4 = *(const f32x4*)(gv + col);
#pragma unroll
                for (int ai = 0; ai < 2; ++ai)
#pragma unroll
                    for (int m = 0; m < 4; ++m) { const int r = ai * HALF + wr * 64 + m * 16 + fr;
                        const f32x4 xs = *(const f32x4*)(src + (size_t)r * 1024 + col);
                        *(f32x4*)(T + ((size_t)pm * BM + r) * 1024 + col) = xs * alpha + g4 * acc[ai][bj][m][n]; } }
    }
};
struct OrderLat {
    StaticOrder S;
    __device__ __forceinline__ bool next(int i, Unit& u) const { if (!S.next(i, u)) return false; u.pm = (u.pm >> 6) * 68 + (u.pm & 63); return true; }
    __device__ __forceinline__ void a_ready(const Unit&) const {}
    __device__ __forceinline__ void done(const Unit&) const {}
};
template <class Epi, class Sched, bool ALIGN_EPI = false, bool SP2 = false>
__device__ __forceinline__ void gemm_phase(PG8_LAS unsigned char* lds, const Gemm g, const Sched& S, const Epi& E) {
    int tid_ = threadIdx.x; asm volatile("" : "+v"(tid_));
    const int tid = tid_, wid = __builtin_amdgcn_readfirstlane(tid >> 6), lane = tid & 63, wr = wid >> 2, wc = wid & 3, fr = lane & 15, fq = lane >> 4;
    const int K = g.K, nt = K / BK;
    unsigned voffA[2], voffB[2];
#pragma unroll
    for (int i = 0; i < 2; ++i) { int R, C; stage_rc(tid * 16 + i * 8192, R, C); const int Rb = Epi::PERM ? ((R & ~31) + perm32(R & 31)) : R;
        voffA[i] = (unsigned)(R * K + C) * 2u; voffB[i] = (unsigned)(Rb * K + C) * 2u; }
    const size_t kstep = (size_t)(BK * 2);
    const size_t hstep = (size_t)HALF * K * 2;
    const size_t tstep = 2 * hstep;
    const unsigned ldsw = (unsigned)wid * 1024u;
    const int aoff = lds_byte(wr * 64 + fr, fq * 8), boff = lds_byte(wc * 32 + fr, fq * 8);
#define PG8_SA(b, h) (((b) * 2 + (h)) * HTB)
#define PG8_SB(b, h) ((4 + (b) * 2 + (h)) * HTB)
#define PG8_STAGE(bufoff, gbase, voff) do { _Pragma("unroll") for (int _i = 0; _i < 2; ++_i) \
        __builtin_amdgcn_global_load_lds((const unsigned*)((const char*)(gbase) + (voff)[_i]), (PG8_LAS unsigned*)(lds + (bufoff) + ldsw + _i * 8192), 16, 0, 0); } while (0)
#define PG8_LDA(dst, b, h) do { _Pragma("unroll") for (int m = 0; m < 4; ++m) _Pragma("unroll") for (int k = 0; k < 2; ++k) dst[m][k] = *(const PG8_LAS bf16x8*)(lds + PG8_SA(b, h) + aoff + m * 2048 + k * 1024); } while (0)
#define PG8_LDB(dst, b, h) do { _Pragma("unroll") for (int n = 0; n < 2; ++n) _Pragma("unroll") for (int k = 0; k < 2; ++k) dst[n][k] = *(const PG8_LAS bf16x8*)(lds + PG8_SB(b, h) + boff + n * 2048 + k * 1024); } while (0)
#define PG8_MMA(ai, bj, At, Bt) do { __builtin_amdgcn_s_setprio(1); _Pragma("unroll") for (int m = 0; m < 4; ++m) _Pragma("unroll") for (int n = 0; n < 2; ++n) _Pragma("unroll") for (int k = 0; k < 2; ++k) \
        acc[ai][bj][m][n] = __builtin_amdgcn_mfma_f32_16x16x32_bf16(Bt[n][k], At[m][k], acc[ai][bj][m][n], 0, 0, 0); __builtin_amdgcn_s_setprio(0); } while (0)
#define PG8_WAIT_V(n) asm volatile("s_waitcnt vmcnt(" #n ")" ::: "memory")
#define PG8_WAIT_L(n) asm volatile("s_waitcnt lgkmcnt(" #n ")" ::: "memory")
#define PG8_BAR __builtin_amdgcn_s_barrier()
#define PG8_SCHED __builtin_amdgcn_sched_barrier(0)
    Unit cur, nxt; int ui = 0;
    if (!S.next(0, cur)) return;
    f32x4 acc[2][2][4][2];
#pragma unroll
    for (int a = 0; a < 2; ++a)
#pragma unroll
        for (int b = 0; b < 2; ++b)
#pragma unroll
            for (int m = 0; m < 4; ++m)
#pragma unroll
                for (int n = 0; n < 2; ++n) acc[a][b][m][n] = (f32x4){0.f, 0.f, 0.f, 0.f};
    bf16x8 At[4][2], B0[2][2], B1[2][2];
    const char* cA = (const char*)g.A + (size_t)cur.pm * tstep; const char* cB = (const char*)g.Bt + (size_t)cur.pn * tstep;
    S.a_ready(cur);
    if constexpr (SP2) {
        PG8_STAGE(PG8_SB(0, 0), cB, voffB); PG8_STAGE(PG8_SB(0, 1), cB + hstep, voffB); PG8_STAGE(PG8_SA(0, 0), cA, voffA); PG8_STAGE(PG8_SA(0, 1), cA + hstep, voffA);
        if (wr == 1) PG8_BAR;
        PG8_WAIT_V(2); PG8_BAR;
        PG8_STAGE(PG8_SB(1, 0), cB + kstep, voffB); PG8_STAGE(PG8_SA(1, 0), cA + kstep, voffA); PG8_STAGE(PG8_SB(1, 1), cB + hstep + kstep, voffB);
        PG8_WAIT_V(6); PG8_BAR;
    } else {
        PG8_STAGE(PG8_SB(0, 0), cB, voffB); PG8_STAGE(PG8_SA(0, 0), cA, voffA); PG8_STAGE(PG8_SB(0, 1), cB + hstep, voffB); PG8_STAGE(PG8_SA(0, 1), cA + hstep, voffA);
        if (wr == 1) PG8_BAR;
        PG8_WAIT_V(4); PG8_BAR;
        PG8_STAGE(PG8_SB(1, 0), cB + kstep, voffB); PG8_STAGE(PG8_SA(1, 0), cA + kstep, voffA); PG8_STAGE(PG8_SB(1, 1), cB + hstep + kstep, voffB);
        PG8_WAIT_V(6); PG8_BAR;
    }
    for (;;) {
        const bool has_next = S.next(ui + 1, nxt);
        const char* nA = has_next ? (const char*)g.A + (size_t)nxt.pm * tstep : cA; const char* nB = has_next ? (const char*)g.Bt + (size_t)nxt.pn * tstep : cB;
        for (int t = 0; t < nt; t += 2) {
            const bool last = (t == nt - 2);
            const char* a1 = cA + (size_t)(t + 1) * kstep;
            const char* a2 = last ? nA : cA + (size_t)(t + 2) * kstep; const char* b2 = last ? nB : cB + (size_t)(t + 2) * kstep;
            const char* a3 = a2 + kstep; const char* b3 = b2 + kstep;
            if (last && has_next) S.a_ready(nxt);
            if constexpr (SP2) {
            PG8_LDB(B0, 0, 0); PG8_LDB(B1, 0, 1); PG8_SCHED; PG8_LDA(At, 0, 0); PG8_STAGE(PG8_SA(1, 1), a1 + hstep, voffA);
            PG8_WAIT_V(8); PG8_WAIT_L(0); PG8_BAR; PG8_MMA(0, 0, At, B0); PG8_MMA(0, 1, At, B1); PG8_BAR; PG8_SCHED;
            PG8_LDA(At, 0, 1); PG8_STAGE(PG8_SB(0, 0), b2, voffB); PG8_STAGE(PG8_SB(0, 1), b2 + hstep, voffB); PG8_STAGE(PG8_SA(0, 0), a2, voffA);
            PG8_WAIT_V(8); PG8_WAIT_L(0); PG8_BAR; PG8_MMA(1, 0, At, B0); PG8_MMA(1, 1, At, B1); PG8_BAR; PG8_SCHED;
            PG8_LDB(B0, 1, 0); PG8_LDB(B1, 1, 1); PG8_SCHED; PG8_LDA(At, 1, 0); PG8_STAGE(PG8_SA(0, 1), a2 + hstep, voffA);
            PG8_WAIT_V(8); PG8_WAIT_L(0); PG8_BAR; PG8_MMA(0, 0, At, B0); PG8_MMA(0, 1, At, B1); PG8_BAR; PG8_SCHED;
            PG8_LDA(At, 1, 1); PG8_STAGE(PG8_SB(1, 0), b3, voffB); PG8_STAGE(PG8_SB(1, 1), b3 + hstep, voffB); PG8_STAGE(PG8_SA(1, 0), a3, voffA);
            PG8_WAIT_V(8); PG8_WAIT_L(0); PG8_BAR; PG8_MMA(1, 0, At, B0); PG8_MMA(1, 1, At, B1); PG8_BAR; PG8_SCHED;
            } else {
            PG8_LDB(B0, 0, 0); PG8_SCHED; PG8_LDA(At, 0, 0); PG8_STAGE(PG8_SA(1, 1), a1 + hstep, voffA);
            PG8_WAIT_L(8); PG8_BAR; PG8_WAIT_L(0); PG8_MMA(0, 0, At, B0); PG8_BAR; PG8_SCHED;
            PG8_LDB(B1, 0, 1); PG8_STAGE(PG8_SB(0, 0), b2, voffB);
            PG8_BAR; PG8_WAIT_L(0); PG8_MMA(0, 1, At, B1); PG8_BAR;
            PG8_LDA(At, 0, 1); PG8_STAGE(PG8_SA(0, 0), a2, voffA);
            PG8_BAR; PG8_WAIT_L(0); PG8_MMA(1, 0, At, B0); PG8_BAR; PG8_SCHED;
            PG8_STAGE(PG8_SB(0, 1), b2 + hstep, voffB);
            PG8_WAIT_V(6); PG8_BAR; PG8_MMA(1, 1, At, B1); PG8_BAR;
            PG8_LDB(B0, 1, 0); PG8_SCHED; PG8_LDA(At, 1, 0); PG8_STAGE(PG8_SA(0, 1), a2 + hstep, voffA);
            PG8_WAIT_L(8); PG8_BAR; PG8_WAIT_L(0); PG8_MMA(0, 0, At, B0); PG8_BAR; PG8_SCHED;
            PG8_LDB(B1, 1, 1); PG8_STAGE(PG8_SB(1, 0), b3, voffB);
            PG8_BAR; PG8_WAIT_L(0); PG8_MMA(0, 1, At, B1); PG8_BAR;
            PG8_LDA(At, 1, 1); PG8_STAGE(PG8_SA(1, 0), a3, voffA);
            PG8_BAR; PG8_WAIT_L(0); PG8_MMA(1, 0, At, B0); PG8_BAR; PG8_SCHED;
            PG8_STAGE(PG8_SB(1, 1), b3 + hstep, voffB);
            PG8_WAIT_V(6); PG8_BAR; PG8_MMA(1, 1, At, B1); PG8_BAR;
            }
        }
        if constexpr (ALIGN_EPI) { if (wr == 0) PG8_BAR; }
        if constexpr (!Epi::AFTER_DRAIN) { E(acc, cur, wr, wc, fr, fq); S.done(cur); }
        if (!has_next) break;
#pragma unroll
        for (int a = 0; a < 2; ++a)
#pragma unroll
            for (int b = 0; b < 2; ++b)
#pragma unroll
                for (int m = 0; m < 4; ++m)
#pragma unroll
                    for (int n = 0; n < 2; ++n) acc[a][b][m][n] = (f32x4){0.f, 0.f, 0.f, 0.f};
        cur = nxt; cA = nA; cB = nB; ++ui;
        if constexpr (ALIGN_EPI) { if (wr == 1) PG8_BAR; }
    }
    PG8_WAIT_V(0);
    if constexpr (!ALIGN_EPI) { if (wr == 0) PG8_BAR; }
    PG8_BAR;
    if constexpr (Epi::AFTER_DRAIN) { E.fused(acc, cur, wr, wc, fr, fq, lds, wid, lane); S.done(cur); }
#undef PG8_SA
#undef PG8_SB
#undef PG8_STAGE
#undef PG8_LDA
#undef PG8_LDB
#undef PG8_MMA
#undef PG8_WAIT_V
#undef PG8_WAIT_L
#undef PG8_BAR
#undef PG8_SCHED
}
}
constexpr int DM = 1024, NBATCH = 8, SEQ = 4096, LCTX = 256, NIN = 4880;
constexpr int HLAT = 4 * SEQ, HCTX = 4 * LCTX, HROWS = HLAT + HCTX  , MTOT = 2 * HROWS  ;
constexpr int UR_LD = 3072, Y_LD = 1536;
constexpr int UR_Z = 1024, UR_DT = 1536, UR_Q = 1792, UR_K = 2304, UR_V = 2432, UR_ZA = 2560;
constexpr int NWAVES = 8, NTHR = 512;
constexpr size_t MiB = 1u << 20;
constexpr size_t WS_CTL = 0, CTL_ZERO_BYTES = 1 * MiB;
constexpr size_t WS_MOD = 1 * MiB;
constexpr size_t WS_ROPE = 1 * MiB + 256 * 1024;
constexpr size_t WS_TW = 1 * MiB + 512 * 1024;
constexpr size_t WS_H3 = 2 * MiB;
constexpr size_t WS_KC = 5 * MiB;
constexpr size_t WS_WHY = 8 * MiB;
constexpr size_t WS_WR = 16 * MiB;
constexpr size_t WS_WO = 28 * MiB;
constexpr size_t WS_SPEC = 36 * MiB;
constexpr int SPEC_LD = 4104;
constexpr size_t WS_XN = 101 * MiB;
constexpr size_t WS_Y = 169 * MiB;
constexpr size_t WS_UHY = 271 * MiB;
constexpr size_t WS_UR = 339 * MiB;
constexpr size_t WS_T = 271 * MiB;
constexpr size_t WS_KFULL = 271 * MiB;
constexpr size_t WS_XBC = 441 * MiB;
constexpr size_t WS_STATE = 475 * MiB;
constexpr size_t WS_DTA = 509 * MiB;
constexpr size_t WS_YS = WS_XN;
constexpr size_t WS_END = 512 * MiB;
constexpr int CW_BAR = 4096, CW_CTR = 16384;
constexpr int LDS_BYTES = 155648;
constexpr int LDSCTL_OFF = 154624;

#define GAS __attribute__((address_space(1)))
#define LAS __attribute__((address_space(3)))
typedef unsigned short bf16;
typedef unsigned v4u __attribute__((ext_vector_type(4)));
typedef unsigned v2u __attribute__((ext_vector_type(2)));
typedef float f32x4 __attribute__((ext_vector_type(4)));
typedef float f32x2 __attribute__((ext_vector_type(2)));
#define LDS_WAIT() asm volatile("s_waitcnt lgkmcnt(0)" ::: "memory")
__device__ __forceinline__ unsigned f2bf(float f) { unsigned u = __builtin_bit_cast(unsigned, f); return (u + 0x7fffu + ((u >> 16) & 1u)) >> 16; }
__device__ __forceinline__ unsigned pk2(float lo, float hi) { return f2bf(lo) | (f2bf(hi) << 16); }
__device__ __forceinline__ float bf2f(unsigned short h) { return __builtin_bit_cast(float, (unsigned)h << 16); }
__device__ __forceinline__ float bflo(unsigned w) { return __builtin_bit_cast(float, w << 16); }
__device__ __forceinline__ float bfhi(unsigned w) { return __builtin_bit_cast(float, w & 0xffff0000u); }
__device__ __forceinline__ float siluf(float x) { return x / (1.f + __expf(-x)); }
__device__ __forceinline__ float wave_sum(float v) {
#pragma unroll
    for (int o = 1; o < 64; o <<= 1) v += __shfl_xor(v, o);
    return v;
}

#define XB_TMO      128
#define XB_XCNT(j)  (256  + 64 * (j))
#define XB_XSUB(j)  (1280 + 64 * (j))
#define XB_XGEN(j)  (2304 + 64 * (j))
#define XB_TOP      3328
#define XB_TOPGEN   3392
#define XCD_BAR_WORDS 3456
#define XB_SPIN_CAP (1u << 22)
__device__ __forceinline__ unsigned xb_ld(unsigned* p)              { return __hip_atomic_load(p, __ATOMIC_RELAXED, __HIP_MEMORY_SCOPE_AGENT); }
__device__ __forceinline__ unsigned xb_add(unsigned* p, unsigned v) { return __hip_atomic_fetch_add(p, v, __ATOMIC_RELAXED, __HIP_MEMORY_SCOPE_AGENT); }
__device__ __forceinline__ unsigned xb_xcc_id() { return (unsigned)__builtin_amdgcn_s_getreg((3 << 11) | 20) & 0xFu; }
#define XB_SPIN(cond, bar) do { unsigned _sp = 0; while (cond) { __builtin_amdgcn_s_sleep(1); \
    if ((++_sp & 255u) == 0u) { if (xb_ld(&(bar)[XB_TMO])) break; if (_sp > XB_SPIN_CAP) { atomicAdd(&(bar)[XB_TMO], 1u); break; } } } } while (0)
struct XcdBarrier { unsigned* bar; unsigned x; volatile LAS unsigned* st; };
__device__ __forceinline__ XcdBarrier xcd_barrier_post(unsigned* bar, volatile LAS unsigned* st) {
    XcdBarrier b; b.bar = bar; b.x = xb_xcc_id(); b.st = st;
    if (threadIdx.x == 0) (void)xb_add(&bar[XB_XCNT(b.x)], 1u);
    return b;
}
__device__ __forceinline__ void xcd_barrier_complete(unsigned* bar, unsigned x, unsigned& nloc, unsigned& nx) {
    const unsigned G = gridDim.x * gridDim.y * gridDim.z;
    unsigned sum, cnt, mine, sp = 0u;
    for (;;) {
        sum = 0u; cnt = 0u; mine = 0u;
#pragma unroll
        for (unsigned j = 0; j < 16; ++j) { const unsigned c = xb_ld(&bar[XB_XCNT(j)]); sum += c; cnt += (c > 0u) ? 1u : 0u; mine = (j == x) ? c : mine; }
        if (sum == G) break;
        __builtin_amdgcn_s_sleep(1);
        if ((++sp & 255u) == 0u) { if (xb_ld(&bar[XB_TMO])) break; if (sp > XB_SPIN_CAP) { atomicAdd(&bar[XB_TMO], 1u); break; } }
    }
    nloc = mine > 0u ? mine : 1u; nx = cnt > 0u ? cnt : 1u;
}
__device__ __forceinline__ void xcd_barrier(const XcdBarrier& b) {
    asm volatile("s_waitcnt vmcnt(0)" ::: "memory");
    __syncthreads();
    if (threadIdx.x == 0) {
        unsigned* bar = b.bar;
        __builtin_amdgcn_s_waitcnt(0);
        const unsigned bx = xb_xcc_id();
        unsigned nloc = b.st[0], nx = b.st[1];
        if (nloc == 0u) { xcd_barrier_complete(bar, bx, nloc, nx); b.st[0] = nloc; b.st[1] = nx; }
        const unsigned old = xb_add(&bar[XB_XSUB(bx)], 1u);
        const unsigned gen = old / nloc;
        if (old + 1u == (gen + 1u) * nloc) {
            __builtin_amdgcn_fence(__ATOMIC_RELEASE, "agent");
            asm volatile("s_waitcnt vmcnt(0)" ::: "memory");
            const unsigned og = xb_add(&bar[XB_TOP], 1u);
            const unsigned tg = og / nx;
            if (og + 1u == (tg + 1u) * nx) xb_add(&bar[XB_TOPGEN], 1u);
            else XB_SPIN(xb_ld(&bar[XB_TOPGEN]) == tg, bar);
            __builtin_amdgcn_fence(__ATOMIC_ACQUIRE, "agent");
            xb_add(&bar[XB_XGEN(bx)], 1u);
            asm volatile("s_waitcnt vmcnt(0)" ::: "memory");
        } else {
            XB_SPIN(xb_ld(&bar[XB_XGEN(bx)]) == gen, bar);
            __builtin_amdgcn_fence(__ATOMIC_ACQUIRE, "agent");
            asm volatile("s_waitcnt vmcnt(0)" ::: "memory");
        }
    }
    __syncthreads();
}

struct Args { const float* in[28]; float* out; unsigned char* ws; int ph_lo, ph_hi; };
enum { I_X = 0, I_C, I_CTX, I_CCTX, I_WMOD, I_BMOD, I_WIN, I_HCW, I_HCB, I_FW1, I_FB1, I_FW2, I_FB2, I_FW3, I_FB3, I_FFREQ, I_FWOUT, I_HBIAS,
       I_SCW, I_SCB, I_DTB, I_ALOG, I_SD, I_SNW, I_SINK, I_WOUT, I_LNG, I_LNB };
struct Frame {
    LAS unsigned char* lds; int tid, lane, wave, bid, G;
    float* out; unsigned char* ws;
    __device__ __forceinline__ void refresh() {
        int t = threadIdx.x; asm volatile("" : "+v"(t)); tid = t; lane = t & 63; wave = __builtin_amdgcn_readfirstlane(t >> 6);
    }
};
__device__ __forceinline__ int next_tile(Frame& F, unsigned* ctr) {
    volatile LAS int* slot = (volatile LAS int*)(F.lds + LDSCTL_OFF + 64);
    __syncthreads();
    if (F.tid == 0) *slot = (int)atomicAdd(ctr, 1u);
    __syncthreads();
    return *slot;
}

__device__ __forceinline__ void p0_transpose_item(const float* W, int ldw, int K, int nblk, bf16* WT, int mode, LAS float* scr, int item, int lane) {
    const int kb = item / nblk, nb = item % nblk, k0 = 64 * kb, n0 = 32 * nb;
    const int r = n0 + (lane & 31);
    int src = r;
    if (mode == 1) src = (r < 1552) ? (2048 + r) : (r < 1792 ? -1 : 3600 + (r - 1792));
#pragma unroll 8
    for (int i = 0; i < 32; ++i) { const int kk = 2 * i + (lane >> 5); scr[kk * 33 + (lane & 31)] = (src >= 0) ? W[(size_t)(k0 + kk) * ldw + src] : 0.f; }
    LDS_WAIT(); asm volatile("" ::: "memory");
    const int c = lane & 7;
#pragma unroll
    for (int j = 0; j < 4; ++j) { const int n = (lane >> 3) + 8 * j; const LAS float* s = scr + (8 * c) * 33 + n;
        v4u o; o.x = pk2(s[0 * 33], s[1 * 33]); o.y = pk2(s[2 * 33], s[3 * 33]); o.z = pk2(s[4 * 33], s[5 * 33]); o.w = pk2(s[6 * 33], s[7 * 33]);
        *(v4u*)(WT + (size_t)(n0 + n) * K + k0 + 8 * c) = o; }
    LDS_WAIT(); asm volatile("" ::: "memory");
}
__device__ __forceinline__ void phase0(Frame& F, const Args& A) {
    F.refresh();
    const int gw = F.bid * NWAVES + F.wave, NGW = F.G * NWAVES;
    {
        LAS float* scr = (LAS float*)(F.lds + F.wave * 16384);
        constexpr int I_HY = 16 * 64, I_R = 16 * 96, I_O = 24 * 32, I_L = I_HY + I_R + I_O;
        for (int it = gw; it < 2 * I_L; it += NGW) {
            const int l = it / I_L; int r = it % I_L;
            const float* win = A.in[I_WIN] + (size_t)l * 1024 * NIN;
            if (r < I_HY) { p0_transpose_item(win, NIN, 1024, 64, (bf16*)(F.ws + WS_WHY) + (size_t)l * 2048 * 1024, 0, scr, r, F.lane); continue; } r -= I_HY;
            if (r < I_R) { p0_transpose_item(win, NIN, 1024, 96, (bf16*)(F.ws + WS_WR) + (size_t)l * 3072 * 1024, 1, scr, r, F.lane); continue; } r -= I_R;
            p0_transpose_item(A.in[I_WOUT] + (size_t)l * 1536 * 1024, 1024, 1536, 32, (bf16*)(F.ws + WS_WO) + (size_t)l * 1024 * 1536, 0, scr, r, F.lane);
        }
    }
    __syncthreads();
    {
        float* tw = (float*)(F.ws + WS_TW); float* rope = (float*)(F.ws + WS_ROPE);
        for (int j = F.bid * NTHR + F.tid; j < 4096; j += F.G * NTHR) { float s, c; sincospif((float)j * (1.0f / 4096.0f), &s, &c); tw[2 * j] = c; tw[2 * j + 1] = -s; }
        for (int j = F.bid * NTHR + F.tid; j < 1024; j += F.G * NTHR) { const int pos = j >> 4, i = j & 15;
            const float inv = exp2f(-(float)i * (13.287712379549449f / 16.0f)); const float ang = (float)pos * inv;
            rope[2 * j] = cosf(ang); rope[2 * j + 1] = sinf(ang); }
    }
    {
        LAS float* red = (LAS float*)F.lds;
        float* MOD = (float*)(F.ws + WS_MOD);
        for (int it = F.bid; it < 96; it += F.G) {
            const int l = it / 48, j0 = (it % 48) * 64, j = j0 + F.lane;
            float acc[9];
#pragma unroll
            for (int v = 0; v < 9; ++v) acc[v] = 0.f;
            const float* wm = A.in[I_WMOD] + (size_t)l * 1024 * 3072;
            for (int k = F.wave * 128; k < F.wave * 128 + 128; ++k) {
                const float w = wm[(size_t)k * 3072 + j];
#pragma unroll
                for (int v = 0; v < 9; ++v) { const float cv = (v < 8) ? A.in[I_C][v * 1024 + k] : A.in[I_CCTX][k]; acc[v] += siluf(cv) * w; }
            }
            __syncthreads();
#pragma unroll
            for (int v = 0; v < 9; ++v) red[(F.wave * 9 + v) * 64 + F.lane] = acc[v];
            __syncthreads();
            for (int idx = F.tid; idx < 576; idx += NTHR) { const int v = idx >> 6, ln = idx & 63; float s = A.in[I_BMOD][l * 3072 + j0 + ln];
#pragma unroll
                for (int w = 0; w < 8; ++w) s += red[(w * 9 + v) * 64 + ln];
                MOD[(size_t)(l * 9 + v) * 3072 + j0 + ln] = s; }
            __syncthreads();
        }
    }
    {
        LAS float* zs = (LAS float*)F.lds;
        LAS float* ha = zs + 512; LAS float* hb = ha + 512;
        float* H3 = (float*)(F.ws + WS_H3);
        for (int it = F.bid; it < 1088; it += F.G) {
            const int l = it / 544, tt0 = (it % 544) * 8, ti = F.tid >> 6, j = F.tid & 63, tt = tt0 + ti;
            const int L = tt < 4096 ? 4096 : 256, t = tt < 4096 ? tt : tt - 4096;
            __syncthreads();
            if (j < 33) {
                float z;
                if (j == 0) z = (float)t / (float)(L - 1);
                else { const int i = (j - 1) & 15; const float f = 1e-4f + (float)i * ((15.0f - 1e-4f) / 15.0f);
                    float rev = f * (float)t / (float)L; rev -= floorf(rev); float s, c; sincospif(2.0f * rev, &s, &c); z = (j <= 16) ? c : -s; }
                zs[ti * 64 + j] = z;
            }
            __syncthreads();
            const float fr = A.in[I_FFREQ][l * 64 + j];
            { float a = A.in[I_FB1][l * 64 + j]; const float* w1 = A.in[I_FW1] + l * 33 * 64;
              for (int i = 0; i < 33; ++i) a += zs[ti * 64 + i] * w1[i * 64 + j];
              ha[ti * 64 + j] = sinf(fr * a); }
            __syncthreads();
            { float a = A.in[I_FB2][l * 64 + j]; const float* w2 = A.in[I_FW2] + l * 64 * 64;
              for (int i = 0; i < 64; ++i) a += ha[ti * 64 + i] * w2[i * 64 + j];
              hb[ti * 64 + j] = sinf(fr * a); }
            __syncthreads();
            { float a = A.in[I_FB3][l * 64 + j]; const float* w3 = A.in[I_FW3] + l * 64 * 64;
              for (int i = 0; i < 64; ++i) a += hb[ti * 64 + i] * w3[i * 64 + j];
              H3[((size_t)l * 4352 + tt) * 64 + j] = sinf(fr * a); }
        }
        __syncthreads();
    }
}

__device__ __forceinline__ void ln_stats(const f32x4 (&v)[4], float& mean, float& rstd, float eps) {
    float s = 0.f;
#pragma unroll
    for (int j = 0; j < 4; ++j) s += (v[j].x + v[j].y) + (v[j].z + v[j].w);
    mean = wave_sum(s) * (1.f / 1024.f); float s2 = 0.f;
#pragma unroll
    for (int j = 0; j < 4; ++j) { const f32x4 d = v[j] - mean; s2 += (d.x * d.x + d.y * d.y) + (d.z * d.z + d.w * d.w); }
    rstd = 1.f / sqrtf(wave_sum(s2) * (1.f / 1024.f) + eps);
}
__device__ __forceinline__ void ln_mod_store(const f32x4 (&v)[4], const float* modv, bf16* orow, int lane) {
    float mean, rstd; ln_stats(v, mean, rstd, 1e-6f);
    unsigned long long* o8 = (unsigned long long*)orow + lane;
#pragma unroll
    for (int j = 0; j < 4; ++j) { const f32x4 sh = *((const f32x4*)modv + lane + 64 * j), sc = *((const f32x4*)(modv + 1024) + lane + 64 * j);
        const f32x4 y = (v[j] - mean) * rstd * (1.f + sc) + sh;
        o8[64 * j] = (unsigned long long)pk2(y.x, y.y) | ((unsigned long long)pk2(y.z, y.w) << 32); }
}
__device__ __forceinline__ void row_map(int m, int& islat, int& b, int& t) {
    const int hf = m / HROWS, r = m % HROWS;
    if (r < HLAT) { islat = 1; b = hf * 4 + (r >> 12); t = r & 4095; }
    else { islat = 0; const int rc = r - HLAT; b = hf * 4 + (rc >> 8); t = rc & 255; }
}

__device__ __forceinline__ void phase1(Frame& F, const Args& A) {
    F.refresh();
    const int gw = F.bid * NWAVES + F.wave, NGW = F.G * NWAVES;
    const float* MOD = (const float*)(F.ws + WS_MOD);
    bf16* XN = (bf16*)(F.ws + WS_XN);
    for (int m = gw; m < MTOT; m += NGW) {
        int islat, b, t; row_map(m, islat, b, t);
        const float* src = islat ? A.in[I_X] + ((size_t)b * SEQ + t) * DM : A.in[I_CTX] + ((size_t)b * LCTX + t) * DM;
        const float* modv = MOD + (size_t)(0 * 9 + (islat ? b : 8)) * 3072;
        f32x4 v[4];
#pragma unroll
        for (int j = 0; j < 4; ++j) v[j] = *((const f32x4*)src + F.lane + 64 * j);
        ln_mod_store(v, modv, XN + (size_t)m * DM, F.lane);
    }
    {
        LAS float* hs = (LAS float*)F.lds;
        const float* H3 = (const float*)(F.ws + WS_H3);
        const float min_decay = -3.0701134573253945f, max_decay = -15.350567286626973f;
        for (int it = F.bid; it < 528; it += F.G) {
            int l, g; if (it < 272) { l = 0; g = it; } else { l = 1; g = it - 272; }
            int L, t0, N2; const float* hbase; float* dst;
            if (g < 256) { L = 4096; t0 = g * 16; N2 = 8192; hbase = H3 + ((size_t)l * 4352 + t0) * 64; dst = (float*)(F.ws + WS_KFULL) + (size_t)l * 2 * 512 * 8192; }
            else { L = 256; t0 = (g - 256) * 16; N2 = 512; hbase = H3 + ((size_t)l * 4352 + 4096 + t0) * 64; dst = (float*)(F.ws + WS_KC); }
            __syncthreads();
            hs[F.tid] = hbase[F.tid]; hs[F.tid + 512] = hbase[F.tid + 512];
            __syncthreads();
            const int c = F.tid;
            const float absd = fabsf(min_decay + (float)c * ((max_decay - min_decay) / 511.0f));
            for (int conv = 0; conv < 2; ++conv) {
                const float* wo = A.in[I_FWOUT] + (size_t)l * 64 * 2048 + conv * 1024 + c;
                float af[16], ab[16];
#pragma unroll
                for (int i = 0; i < 16; ++i) { af[i] = 0.f; ab[i] = 0.f; }
                for (int k = 0; k < 64; ++k) { const float wf = wo[(size_t)k * 2048], wb = wo[(size_t)k * 2048 + 512];
#pragma unroll
                    for (int i = 0; i < 16; ++i) { const float h = hs[i * 64 + k]; af[i] += h * wf; ab[i] += h * wb; } }
#pragma unroll
                for (int i = 0; i < 16; ++i) { const float win = __expf(-((float)(t0 + i) / (float)(L - 1)) * absd); af[i] *= win; ab[i] *= win; }
                float* row = dst + (size_t)(conv * 512 + c) * N2;
                if (t0 == 0) { af[0] += ab[0]; row[L] = 0.f; }
#pragma unroll
                for (int q = 0; q < 4; ++q) *(f32x4*)(row + t0 + 4 * q) = (f32x4){af[4 * q], af[4 * q + 1], af[4 * q + 2], af[4 * q + 3]};
#pragma unroll
                for (int i = 0; i < 16; ++i) { const int t = t0 + i; if (t >= 1) row[N2 - t] = ab[i]; }
            }
        }
        __syncthreads();
    }
}

__device__ __forceinline__ int padi(int i) { return i + (i >> 5); }
constexpr int FFT_BUF_ELEMS = 8192 + 256;
__device__ __forceinline__ f32x2 cmul(f32x2 a, f32x2 w) { return (f32x2){a.x * w.x - a.y * w.y, a.x * w.y + a.y * w.x}; }
__device__ __forceinline__ f32x2 cmulc(f32x2 a, f32x2 w) { return (f32x2){a.x * w.x + a.y * w.y, a.y * w.x - a.x * w.y}; }
__device__ constexpr float COS32[16] = {1.0f, 0.98078528040323043f, 0.92387953251128674f, 0.83146961230254524f, 0.70710678118654757f, 0.55557023301960229f, 0.38268343236508984f, 0.19509032201612833f,
                                        0.0f, -0.19509032201612819f, -0.38268343236508973f, -0.55557023301960196f, -0.70710678118654746f, -0.83146961230254535f, -0.92387953251128674f, -0.98078528040323043f};
__device__ constexpr float SIN32[16] = {0.0f, 0.19509032201612825f, 0.38268343236508978f, 0.55557023301960218f, 0.70710678118654746f, 0.83146961230254524f, 0.92387953251128674f, 0.98078528040323043f,
                                        1.0f, 0.98078528040323043f, 0.92387953251128674f, 0.83146961230254546f, 0.70710678118654757f, 0.55557023301960218f, 0.38268343236508989f, 0.19509032201612861f};
__host__ __device__ constexpr int brevk(int q, int k) { int r = 0; for (int i = 0; i < k; ++i) r |= ((q >> i) & 1) << (k - 1 - i); return r; }
template <int R> __device__ __forceinline__ void dif_reg(f32x2 (&x)[R]) {
#pragma unroll
    for (int s = R; s >= 2; s >>= 1) {
#pragma unroll
        for (int blk = 0; blk < R; blk += s) {
#pragma unroll
            for (int p = 0; p < s / 2; ++p) {
                const f32x2 a = x[blk + p], b = x[blk + p + s / 2];
                x[blk + p] = a + b;
                const f32x2 d = a - b;
                const int e = p * (32 / s);
                if (e == 0) x[blk + p + s / 2] = d;
                else if (e == 8) x[blk + p + s / 2] = (f32x2){d.y, -d.x};
                else x[blk + p + s / 2] = (f32x2){d.x * COS32[e] + d.y * SIN32[e], d.y * COS32[e] - d.x * SIN32[e]};
            }
        }
    }
}
template <int R> __device__ __forceinline__ void dit_reg(f32x2 (&x)[R]) {
#pragma unroll
    for (int s = 2; s <= R; s <<= 1) {
#pragma unroll
        for (int blk = 0; blk < R; blk += s) {
#pragma unroll
            for (int p = 0; p < s / 2; ++p) {
                const f32x2 A = x[blk + p], b = x[blk + p + s / 2];
                const int e = p * (32 / s);
                f32x2 B;
                if (e == 0) B = b;
                else if (e == 8) B = (f32x2){-b.y, b.x};
                else B = (f32x2){b.x * COS32[e] - b.y * SIN32[e], b.y * COS32[e] + b.x * SIN32[e]};
                x[blk + p] = A + B; x[blk + p + s / 2] = A - B;
            }
        }
    }
}
template <int K, bool INV> __device__ __forceinline__ void fft_pass(LAS f32x2* buf, const LAS f32x2* tw, int n, int lgst, int tid) {
    constexpr int R = 1 << K;
    const int st = 1 << lgst;
    for (int bf = tid; bf < (8192 >> K); bf += NTHR) {
        const int j = bf & (st - 1), base = (bf >> lgst) * n + j;
        f32x2 x[R];
#pragma unroll
        for (int q = 0; q < R; ++q) x[q] = buf[padi(base + q * st)];
        if (!INV) {
            dif_reg<R>(x);
            if (st > 1) { const f32x2 w1 = tw[j * (8192 / n)]; f32x2 w = w1;
#pragma unroll
                for (int r = 1; r < R; ++r) { x[brevk(r, K)] = cmul(x[brevk(r, K)], w); if (r + 1 < R) w = cmul(w, w1); } }
        } else {
            if (st > 1) { const f32x2 w1 = tw[j * (8192 / n)]; f32x2 w = w1;
#pragma unroll
                for (int r = 1; r < R; ++r) { x[brevk(r, K)] = cmulc(x[brevk(r, K)], w); if (r + 1 < R) w = cmul(w, w1); } }
            dit_reg<R>(x);
        }
#pragma unroll
        for (int q = 0; q < R; ++q) buf[padi(base + q * st)] = x[q];
    }
}
__device__ __forceinline__ void fft_fwd(LAS f32x2* buf, const LAS f32x2* tw, int tid) {
    __syncthreads(); fft_pass<4, false>(buf, tw, 8192, 9, tid);
    __syncthreads(); fft_pass<4, false>(buf, tw, 512, 5, tid);
    __syncthreads(); fft_pass<5, false>(buf, tw, 32, 0, tid);
    __syncthreads();
}
__device__ __forceinline__ void fft_inv(LAS f32x2* buf, const LAS f32x2* tw, int tid) {
    __syncthreads(); fft_pass<5, true>(buf, tw, 32, 0, tid);
    __syncthreads(); fft_pass<4, true>(buf, tw, 512, 5, tid);
    __syncthreads(); fft_pass<4, true>(buf, tw, 8192, 9, tid);
    __syncthreads();
}
__device__ __forceinline__ int brev13(int k) { return (int)(__brev((unsigned)k) >> 19); }
__device__ __forceinline__ void load_tw(Frame& F, LAS f32x2* tw) {
    const f32x2* g = (const f32x2*)(F.ws + WS_TW);
    for (int j = F.tid; j < 4096; j += NTHR) tw[j] = g[j];
}

__device__ __forceinline__ void phase1b(Frame& F) {
    F.refresh();
    LAS f32x2* buf = (LAS f32x2*)F.lds; LAS f32x2* tw = buf + FFT_BUF_ELEMS;
    load_tw(F, tw);
    for (int it = F.bid; it < 1024; it += F.G) {
        const int l = it >> 9, conv = (it >> 8) & 1, pair = it & 255;
        const float* ka = (const float*)(F.ws + WS_KFULL) + ((size_t)(l * 2 + conv) * 512 + 2 * pair) * 8192; const float* kb = ka + 8192;
        __syncthreads();
        for (int i = F.tid; i < 8192; i += NTHR) buf[padi(i)] = (f32x2){ka[i], kb[i]};
        fft_fwd(buf, tw, F.tid);
        f32x4* sp = (f32x4*)(F.ws + WS_SPEC) + (size_t)it * SPEC_LD;
        const float sc = 1.0f / (4.0f * 8192.0f);
        for (int k = F.tid; k <= 4096; k += NTHR) {
            const int kn = (8192 - k) & 8191; const f32x2 zk = buf[padi(brev13(k))], zn = buf[padi(brev13(kn))];
            const f32x2 A = (f32x2){zk.x + zn.x, zk.y - zn.y}, D = (f32x2){zk.x - zn.x, zk.y + zn.y};
            const f32x2 Bk = (f32x2){D.y, -D.x};
            sp[k] = (f32x4){(A.x + Bk.x) * sc, (A.y + Bk.y) * sc, (A.x - Bk.x) * sc, (A.y - Bk.y) * sc};
        }
    }
    __syncthreads();
}

__device__ __forceinline__ float conv3(const bf16* row, int t, int Ls, float w0, float w1, float w2, float b) {
    const float u0 = t > 0 ? bf2f(row[t - 1]) : 0.f, u1 = bf2f(row[t]), u2 = t < Ls - 1 ? bf2f(row[t + 1]) : 0.f;
    return w0 * u0 + w1 * u1 + w2 * u2 + b;
}
__device__ __forceinline__ void pointwise_spec(LAS f32x2* buf, const f32x4* sp, int tid) {
    for (int k = tid; k <= 4096; k += NTHR) {
        const int kn = (8192 - k) & 8191, p = padi(brev13(k)), pn = padi(brev13(kn));
        const f32x4 s = sp[k]; const f32x2 P = (f32x2){s.x, s.y}, M = (f32x2){s.z, s.w};
        const f32x2 zk = buf[p], zn = buf[pn];
        const f32x2 znc = (f32x2){zn.x, -zn.y}, zkc = (f32x2){zk.x, -zk.y};
        const f32x2 yk = cmul(zk, P) + cmul(znc, M);
        const f32x2 yn = cmulc(zn, P) + cmulc(zkc, M);
        buf[p] = yk; if (pn != p) buf[pn] = yn;
    }
}
__device__ __forceinline__ void hyena_tile(Frame& F, const Args& A, int l, int hf, int bl, int pair, LAS f32x2* buf, const LAS f32x2* tw) {
    F.refresh();
    const bf16* U = (const bf16*)(F.ws + WS_UHY) + (size_t)bl * SEQ;
    const int c0 = 2 * pair;
    const float* cw = A.in[I_HCW] + (size_t)l * 3 * 1536; const float* cb = A.in[I_HCB] + (size_t)l * 1536;
    float w[3][2][3], bb[3][2];
#pragma unroll
    for (int s = 0; s < 3; ++s)
#pragma unroll
        for (int ch = 0; ch < 2; ++ch) { const int col = s * 512 + c0 + ch; bb[s][ch] = cb[col];
#pragma unroll
            for (int j = 0; j < 3; ++j) w[s][ch][j] = cw[j * 1536 + col]; }
    const float hb0a = A.in[I_HBIAS][(l * 2 + 0) * 512 + c0], hb0b = A.in[I_HBIAS][(l * 2 + 0) * 512 + c0 + 1];
    const float hb1a = A.in[I_HBIAS][(l * 2 + 1) * 512 + c0], hb1b = A.in[I_HBIAS][(l * 2 + 1) * 512 + c0 + 1];
    const bf16* rv0 = U + (size_t)(c0) * HROWS; const bf16* rv1 = rv0 + HROWS;
    const bf16* r10 = U + (size_t)(512 + c0) * HROWS; const bf16* r11 = r10 + HROWS;
    const bf16* r20 = U + (size_t)(1024 + c0) * HROWS; const bf16* r21 = r20 + HROWS;
    const bf16* rg0 = U + (size_t)(1536 + c0) * HROWS; const bf16* rg1 = rg0 + HROWS;
    const f32x4* sp0 = (const f32x4*)(F.ws + WS_SPEC) + (size_t)((l * 2 + 0) * 256 + pair) * SPEC_LD;
    const f32x4* sp1 = (const f32x4*)(F.ws + WS_SPEC) + (size_t)((l * 2 + 1) * 256 + pair) * SPEC_LD;
    __syncthreads();
#pragma unroll
    for (int i = 0; i < 8; ++i) { const int t = F.tid + NTHR * i;
        const float va = conv3(rv0, t, SEQ, w[0][0][0], w[0][0][1], w[0][0][2], bb[0][0]), vb = conv3(rv1, t, SEQ, w[0][1][0], w[0][1][1], w[0][1][2], bb[0][1]);
        buf[padi(t)] = (f32x2){va, vb}; buf[padi(t + 4096)] = (f32x2){0.f, 0.f}; }
    fft_fwd(buf, tw, F.tid); pointwise_spec(buf, sp0, F.tid); fft_inv(buf, tw, F.tid);
    f32x2 y1r[8];
#pragma unroll
    for (int i = 0; i < 8; ++i) { const int t = F.tid + NTHR * i;
        const f32x2 cv = buf[padi(t)];
        const float va = conv3(rv0, t, SEQ, w[0][0][0], w[0][0][1], w[0][0][2], bb[0][0]), vb = conv3(rv1, t, SEQ, w[0][1][0], w[0][1][1], w[0][1][2], bb[0][1]);
        const float xa = conv3(r10, t, SEQ, w[1][0][0], w[1][0][1], w[1][0][2], bb[1][0]), xb = conv3(r11, t, SEQ, w[1][1][0], w[1][1][1], w[1][1][2], bb[1][1]);
        y1r[i] = (f32x2){xa * (cv.x + va * hb0a), xb * (cv.y + vb * hb0b)};
        buf[padi(t)] = y1r[i]; buf[padi(t + 4096)] = (f32x2){0.f, 0.f}; }
    fft_fwd(buf, tw, F.tid); pointwise_spec(buf, sp1, F.tid); fft_inv(buf, tw, F.tid);
    bf16* Y = (bf16*)(F.ws + WS_Y) + ((size_t)hf * HROWS + (size_t)bl * SEQ) * Y_LD + c0;
#pragma unroll
    for (int i = 0; i < 8; ++i) { const int t = F.tid + NTHR * i;
        const f32x2 cv = buf[padi(t)];
        const float xa = conv3(r20, t, SEQ, w[2][0][0], w[2][0][1], w[2][0][2], bb[2][0]), xb = conv3(r21, t, SEQ, w[2][1][0], w[2][1][1], w[2][1][2], bb[2][1]);
        const float ga = bf2f(rg0[t]), gb = bf2f(rg1[t]);
        const float oa = xa * (cv.x + y1r[i].x * hb1a) * siluf(ga), ob = xb * (cv.y + y1r[i].y * hb1b) * siluf(gb);
        *(unsigned*)(Y + (size_t)t * Y_LD) = pk2(oa, ob); }
}
__device__ __forceinline__ void hyena_ctx_tile(Frame& F, const Args& A, int hf, int bl, int pair, LAS float* ks  , LAS float* sig  ) {
    F.refresh();
    const int l = 0;
    const bf16* U = (const bf16*)(F.ws + WS_UHY) + HLAT + (size_t)bl * LCTX;
    const int ch = F.tid >> 8, t = F.tid & 255, c = 2 * pair + ch;
    const float* cw = A.in[I_HCW] + (size_t)l * 3 * 1536; const float* cb = A.in[I_HCB] + (size_t)l * 1536;
    const float* KC = (const float*)(F.ws + WS_KC);
    __syncthreads();
    for (int idx = F.tid; idx < 2048; idx += NTHR) { const int conv = idx >> 10, chh = (idx >> 9) & 1, i = idx & 511; ks[idx] = KC[(size_t)(conv * 512 + 2 * pair + chh) * 512 + i]; }
    const float vc = conv3(U + (size_t)c * HROWS, t, LCTX, cw[c], cw[1536 + c], cw[3072 + c], cb[c]);
    sig[ch * 256 + t] = vc;
    __syncthreads();
    float acc = 0.f;
    for (int s = 0; s < 256; ++s) acc += ks[(0 * 2 + ch) * 512 + ((t - s) & 511)] * sig[ch * 256 + s];
    const float x1 = conv3(U + (size_t)(512 + c) * HROWS, t, LCTX, cw[512 + c], cw[1536 + 512 + c], cw[3072 + 512 + c], cb[512 + c]);
    const float y1 = x1 * (acc + vc * A.in[I_HBIAS][(l * 2 + 0) * 512 + c]);
    __syncthreads();
    sig[ch * 256 + t] = y1;
    __syncthreads();
    float acc2 = 0.f;
    for (int s = 0; s < 256; ++s) acc2 += ks[(1 * 2 + ch) * 512 + ((t - s) & 511)] * sig[ch * 256 + s];
    const float x2 = conv3(U + (size_t)(1024 + c) * HROWS, t, LCTX, cw[1024 + c], cw[1536 + 1024 + c], cw[3072 + 1024 + c], cb[1024 + c]);
    const float g = bf2f(U[(size_t)(1536 + c) * HROWS + t]);
    const float o = x2 * (acc2 + y1 * A.in[I_HBIAS][(l * 2 + 1) * 512 + c]) * siluf(g);
    bf16* Y = (bf16*)(F.ws + WS_Y) + ((size_t)hf * HROWS + HLAT + (size_t)bl * LCTX + t) * Y_LD + c;
    *Y = (bf16)f2bf(o);
}
typedef short bf16x8 __attribute__((ext_vector_type(8)));
constexpr int SP = 136;
__device__ __forceinline__ float softplusf(float x) { return x > 20.f ? x : log1pf(__expf(x)); }
__device__ __forceinline__ int slot_row0(int bl, int slot) { return slot < 2 ? HLAT + bl * LCTX + slot * 128 : bl * SEQ + (slot - 2) * 128; }
__device__ __forceinline__ bf16x8 frag16(const LAS bf16* base, int row0, int k0, int lane) { return *(const LAS bf16x8*)(base + (row0 + (lane & 15)) * SP + k0 + 8 * (lane >> 4)); }
#define MFMA16(a, b, c) __builtin_amdgcn_mfma_f32_16x16x32_bf16((a), (b), (c), 0, 0, 0)
__device__ __forceinline__ void ssd_prep_tile(Frame& F, const Args& A, int l, int bl, int slot) {
    F.refresh();
    const bf16* UR = (const bf16*)(F.ws + WS_UR); bf16* XBC = (bf16*)(F.ws + WS_XBC); float* DTA = (float*)(F.ws + WS_DTA);
    LAS float* das = (LAS float*)F.lds;
    const int r0 = slot_row0(bl, slot);
    const int seq0 = slot < 2 ? HLAT + bl * LCTX : bl * SEQ, seq1 = seq0 + (slot < 2 ? LCTX : SEQ);
    const float* cw = A.in[I_SCW] + (size_t)l * 3 * 1024; const float* cb = A.in[I_SCB] + (size_t)l * 1024;
    __syncthreads();
    { const int vec = F.tid & 127, c = vec * 8;
      float w0[8], w1[8], w2[8], b[8];
#pragma unroll
      for (int e = 0; e < 8; ++e) { w0[e] = cw[c + e]; w1[e] = cw[1024 + c + e]; w2[e] = cw[2048 + c + e]; b[e] = cb[c + e]; }
      const v4u zero4 = (v4u){0u, 0u, 0u, 0u};
#pragma unroll 2
      for (int i = 0; i < 32; ++i) { const int r = r0 + (F.tid >> 7) + 4 * i;
          const bf16* up = UR + (size_t)r * UR_LD + c;
          const v4u u0 = r > seq0 ? *(const v4u*)(up - UR_LD) : zero4, u1 = *(const v4u*)up, u2 = r < seq1 - 1 ? *(const v4u*)(up + UR_LD) : zero4;
          v4u o;
#pragma unroll
          for (int q = 0; q < 4; ++q) { const float lo = siluf(w0[2 * q] * bflo(u0[q]) + w1[2 * q] * bflo(u1[q]) + w2[2 * q] * bflo(u2[q]) + b[2 * q]);
              const float hi = siluf(w0[2 * q + 1] * bfhi(u0[q]) + w1[2 * q + 1] * bfhi(u1[q]) + w2[2 * q + 1] * bfhi(u2[q]) + b[2 * q + 1]); o[q] = pk2(lo, hi); }
          *(v4u*)(XBC + (size_t)r * 1024 + c) = o; } }
    { const int dh = F.tid & 15; const float a = -__expf(A.in[I_ALOG][l * 16 + dh]), dtb = A.in[I_DTB][l * 16 + dh];
#pragma unroll
      for (int i = 0; i < 4; ++i) { const int tt = (F.tid >> 4) + 32 * i; const float dtv = softplusf(bf2f(UR[(size_t)(r0 + tt) * UR_LD + UR_DT + dh]) + dtb);
          DTA[(size_t)(r0 + tt) * 32 + dh] = dtv; das[tt * 16 + dh] = dtv * a; } }
    __syncthreads();
    if (F.tid < 16) { float run = 0.f;
        if (F.tid < 8) { for (int tt = 0; tt < 128; ++tt) { run += das[tt * 16 + F.tid]; DTA[(size_t)(r0 + tt) * 32 + 16 + F.tid] = run; } }
        else { for (int tt = 127; tt >= 0; --tt) { run += das[tt * 16 + F.tid]; DTA[(size_t)(r0 + tt) * 32 + 16 + F.tid] = run; } } }
}
__device__ __forceinline__ void ssd_state_tile(Frame& F, int bl, int slot, int h) {
    F.refresh();
    const bf16* XBC = (const bf16*)(F.ws + WS_XBC); const float* DTA = (const float*)(F.ws + WS_DTA);
    LAS bf16* xTf = (LAS bf16*)F.lds;
    LAS bf16* xTb = xTf + 64 * SP;
    LAS bf16* BT = xTb + 64 * SP;
    const int r0 = slot_row0(bl, slot), g = h >> 2;
    __syncthreads();
#pragma unroll
    for (int i = 0; i < 2; ++i) { const int idx = F.tid + NTHR * i, s = idx >> 3, p0 = (idx & 7) * 8;
        const float* dr = DTA + (size_t)(r0 + s) * 32;
        const float wf = dr[h] * __expf(DTA[(size_t)(r0 + 127) * 32 + 16 + h] - dr[16 + h]);
        const float wb = dr[8 + h] * __expf(DTA[(size_t)r0 * 32 + 24 + h] - dr[24 + h]);
        const v4u u = *(const v4u*)(XBC + (size_t)(r0 + s) * 1024 + h * 64 + p0);
#pragma unroll
        for (int q = 0; q < 4; ++q) { const float lo = bflo(u[q]), hi = bfhi(u[q]);
            xTf[(p0 + 2 * q) * SP + s] = (bf16)f2bf(lo * wf); xTf[(p0 + 2 * q + 1) * SP + s] = (bf16)f2bf(hi * wf);
            xTb[(p0 + 2 * q) * SP + s] = (bf16)f2bf(lo * wb); xTb[(p0 + 2 * q + 1) * SP + s] = (bf16)f2bf(hi * wb); } }
#pragma unroll
    for (int i = 0; i < 4; ++i) { const int idx = F.tid + NTHR * i, s = idx >> 4, n0 = (idx & 15) * 8;
        const v4u u = *(const v4u*)(XBC + (size_t)(r0 + s) * 1024 + 512 + g * 128 + n0);
#pragma unroll
        for (int q = 0; q < 4; ++q) { BT[(n0 + 2 * q) * SP + s] = (bf16)(u[q] & 0xffffu); BT[(n0 + 2 * q + 1) * SP + s] = (bf16)(u[q] >> 16); } }
    __syncthreads();
    f32x4 acc[2][4];
#pragma unroll
    for (int d = 0; d < 2; ++d)
#pragma unroll
        for (int j = 0; j < 4; ++j) acc[d][j] = (f32x4){0.f, 0.f, 0.f, 0.f};
#pragma unroll
    for (int ks = 0; ks < 4; ++ks) { const bf16x8 a = frag16(BT, 16 * F.wave, 32 * ks, F.lane);
#pragma unroll
        for (int j = 0; j < 4; ++j) { acc[0][j] = MFMA16(a, frag16(xTf, 16 * j, 32 * ks, F.lane), acc[0][j]); acc[1][j] = MFMA16(a, frag16(xTb, 16 * j, 32 * ks, F.lane), acc[1][j]); } }
    bf16* ST = (bf16*)(F.ws + WS_STATE) + ((size_t)((bl * 34 + slot) * 8 + h) * 2) * 8192;
#pragma unroll
    for (int d = 0; d < 2; ++d)
#pragma unroll
        for (int j = 0; j < 4; ++j) { v2u o; o.x = pk2(acc[d][j][0], acc[d][j][1]); o.y = pk2(acc[d][j][2], acc[d][j][3]);
            *(v2u*)(ST + (size_t)d * 8192 + (16 * j + (F.lane & 15)) * 128 + 16 * F.wave + 4 * (F.lane >> 4)) = o; }
}
__device__ __forceinline__ void ssd_scan(Frame& F) {
    F.refresh();
    const float* DTA = (const float*)(F.ws + WS_DTA);
    unsigned* ST = (unsigned*)(F.ws + WS_STATE);
    for (int it = F.bid * NTHR + F.tid; it < 64 * 4096; it += F.G * NTHR) {
        const int e = it & 4095, chain = it >> 12, dir = chain & 1, h = (chain >> 1) & 7, bl = chain >> 4;
        float r0 = 0.f, r1 = 0.f;
        for (int i = 0; i < 34; ++i) {
            const int slot = dir == 0 ? i : (i < 2 ? 1 - i : 35 - i);
            unsigned* p = ST + (((size_t)((bl * 34 + slot) * 8 + h) * 2 + dir) * 8192) / 2 + e;
            const unsigned w = *p;
            const int rr = slot_row0(bl, slot) + (dir == 0 ? 127 : 0);
            const float dec = __expf(DTA[(size_t)rr * 32 + 16 + dir * 8 + h]);
            *p = pk2(r0, r1);
            r0 = r0 * dec + bflo(w); r1 = r1 * dec + bfhi(w);
        }
    }
}
__device__ __forceinline__ void ssd_out_tile(Frame& F, int bl, int slot, int h) {
    F.refresh();
    const bf16* XBC = (const bf16*)(F.ws + WS_XBC); const float* DTA = (const float*)(F.ws + WS_DTA);
    LAS bf16* Cs = (LAS bf16*)F.lds;
    LAS bf16* Bs = Cs + 128 * SP;
    LAS bf16* Mb = Bs + 128 * SP;
    LAS bf16* xT = Mb + 128 * SP;
    LAS bf16* St = xT + 64 * SP;
    LAS float* sc = (LAS float*)(St + 64 * SP);
    const int r0 = slot_row0(bl, slot), g = h >> 2;
    __syncthreads();
#pragma unroll
    for (int i = 0; i < 4; ++i) { const int idx = F.tid + NTHR * i, s = idx >> 4, n0 = (idx & 15) * 8;
        const bf16* src = XBC + (size_t)(r0 + s) * 1024 + 512 + g * 128 + n0;
        *(LAS v4u*)(Bs + s * SP + n0) = *(const v4u*)src; *(LAS v4u*)(Cs + s * SP + n0) = *(const v4u*)(src + 256); }
#pragma unroll
    for (int i = 0; i < 2; ++i) { const int idx = F.tid + NTHR * i, s = idx >> 3, p0 = (idx & 7) * 8;
        const v4u u = *(const v4u*)(XBC + (size_t)(r0 + s) * 1024 + h * 64 + p0);
#pragma unroll
        for (int q = 0; q < 4; ++q) { xT[(p0 + 2 * q) * SP + s] = (bf16)(u[q] & 0xffffu); xT[(p0 + 2 * q + 1) * SP + s] = (bf16)(u[q] >> 16); } }
    { const int s = F.tid & 127, k = F.tid >> 7; const float* dr = DTA + (size_t)(r0 + s) * 32;
      sc[k * 128 + s] = k == 0 ? dr[16 + h] : (k == 1 ? dr[24 + h] : (k == 2 ? dr[h] : dr[8 + h])); }
    __syncthreads();
    f32x4 gT[8];
#pragma unroll
    for (int j = 0; j < 8; ++j) gT[j] = (f32x4){0.f, 0.f, 0.f, 0.f};
#pragma unroll
    for (int ks = 0; ks < 4; ++ks) { const bf16x8 a = frag16(Bs, 16 * F.wave, 32 * ks, F.lane);
#pragma unroll
        for (int j = 0; j < 8; ++j) gT[j] = MFMA16(a, frag16(Cs, 16 * j, 32 * ks, F.lane), gT[j]); }
    f32x4 ysum[4];
#pragma unroll
    for (int j = 0; j < 4; ++j) ysum[j] = (f32x4){0.f, 0.f, 0.f, 0.f};
    const int s0 = 16 * F.wave + 4 * (F.lane >> 4);
#pragma unroll
    for (int dir = 0; dir < 2; ++dir) {
        { const bf16* stg = (const bf16*)(F.ws + WS_STATE) + (((size_t)((bl * 34 + slot) * 8 + h) * 2 + dir) * 8192);
#pragma unroll
          for (int i = 0; i < 2; ++i) { const int idx = F.tid + NTHR * i, p = idx >> 4, n0 = (idx & 15) * 8; *(LAS v4u*)(St + p * SP + n0) = *(const v4u*)(stg + p * 128 + n0); } }
        const LAS float* cum = sc + dir * 128; const LAS float* dts = sc + (2 + dir) * 128;
        float cs[4], ds[4];
#pragma unroll
        for (int e = 0; e < 4; ++e) { cs[e] = cum[s0 + e]; ds[e] = dts[s0 + e]; }
#pragma unroll
        for (int j = 0; j < 8; ++j) { const int lrow = 16 * j + (F.lane & 15); const float cl = cum[lrow]; float mv[4];
#pragma unroll
            for (int e = 0; e < 4; ++e) { const int s = s0 + e; const bool ok = dir == 0 ? (s <= lrow) : (s >= lrow); mv[e] = ok ? gT[j][e] * __expf(cl - cs[e]) * ds[e] : 0.f; }
            v2u o; o.x = pk2(mv[0], mv[1]); o.y = pk2(mv[2], mv[3]); *(LAS v2u*)(Mb + lrow * SP + s0) = o; }
        __syncthreads();
        f32x4 yd[4], yo[4];
#pragma unroll
        for (int j = 0; j < 4; ++j) { yd[j] = (f32x4){0.f, 0.f, 0.f, 0.f}; yo[j] = (f32x4){0.f, 0.f, 0.f, 0.f}; }
#pragma unroll
        for (int ks = 0; ks < 4; ++ks) { const bf16x8 am = frag16(Mb, 16 * F.wave, 32 * ks, F.lane), ac = frag16(Cs, 16 * F.wave, 32 * ks, F.lane);
#pragma unroll
            for (int j = 0; j < 4; ++j) { yd[j] = MFMA16(am, frag16(xT, 16 * j, 32 * ks, F.lane), yd[j]); yo[j] = MFMA16(ac, frag16(St, 16 * j, 32 * ks, F.lane), yo[j]); } }
#pragma unroll
        for (int e = 0; e < 4; ++e) { const float ex = __expf(cum[s0 + e]);
#pragma unroll
            for (int j = 0; j < 4; ++j) ysum[j][e] += yd[j][e] + ex * yo[j][e]; }
        __syncthreads();
    }
    float* YS = (float*)(F.ws + WS_YS) + (size_t)(r0 + s0) * 512 + h * 64 + (F.lane & 15);
#pragma unroll
    for (int e = 0; e < 4; ++e)
#pragma unroll
        for (int j = 0; j < 4; ++j) YS[(size_t)e * 512 + 16 * j] = ysum[j][e];
}
__device__ __forceinline__ void ssd_finish(Frame& F, const Args& A, int l, int hf, int nrows) {
    F.refresh();
    const int gw = F.bid * NWAVES + F.wave, NGW = F.G * NWAVES;
    const bf16* UR = (const bf16*)(F.ws + WS_UR); const bf16* XBC = (const bf16*)(F.ws + WS_XBC);
    const float* YS = (const float*)(F.ws + WS_YS);
    const int c = F.lane * 8;
    const float D = A.in[I_SD][l * 8 + (F.lane >> 3)];
    for (int r = gw; r < nrows; r += NGW) {
        const v4u xx = *(const v4u*)(XBC + (size_t)r * 1024 + c);
        const v4u zz = *(const v4u*)(UR + (size_t)r * UR_LD + UR_Z + c);
        const f32x4 y0 = *(const f32x4*)(YS + (size_t)r * 512 + c), y1 = *(const f32x4*)(YS + (size_t)r * 512 + c + 4);
        float y[8]; float ss = 0.f;
#pragma unroll
        for (int q = 0; q < 4; ++q) { const float ya = q < 2 ? y0[2 * q] : y1[2 * q - 4], yb = q < 2 ? y0[2 * q + 1] : y1[2 * q - 3];
            y[2 * q] = (ya + bflo(xx[q]) * D) * siluf(bflo(zz[q])); y[2 * q + 1] = (yb + bfhi(xx[q]) * D) * siluf(bfhi(zz[q]));
            ss += y[2 * q] * y[2 * q] + y[2 * q + 1] * y[2 * q + 1]; }
#pragma unroll
        for (int o = 1; o < 32; o <<= 1) ss += __shfl_xor(ss, o);
        const float rs = 1.f / sqrtf(ss * (1.f / 256.f) + 1e-5f);
        const float* nw = A.in[I_SNW] + l * 512 + c;
        v4u o4;
        o4.x = pk2(y[0] * rs * nw[0], y[1] * rs * nw[1]); o4.y = pk2(y[2] * rs * nw[2], y[3] * rs * nw[3]);
        o4.z = pk2(y[4] * rs * nw[4], y[5] * rs * nw[5]); o4.w = pk2(y[6] * rs * nw[6], y[7] * rs * nw[7]);
        *(v4u*)((bf16*)(F.ws + WS_Y) + ((size_t)hf * HROWS + r) * Y_LD + 512 + c) = o4;
    }
}
__device__ __forceinline__ void attn_tile(Frame& F, const Args& A, int l, int hf, int bl, int kvh, int qb, bool isctx, LAS float* Ks, LAS float* Vs, const LAS f32x2* rope) {
    F.refresh();
    const bf16* UR = (const bf16*)(F.ws + WS_UR);
    const int g = F.tid >> 7, qi = F.tid & 127, hq = kvh * 4 + g, t = qb * 128 + qi;
    const int qrow = isctx ? HLAT + bl * LCTX + t : bl * SEQ + t;
    float q[64];
    { const bf16* qp = UR + (size_t)qrow * UR_LD + UR_Q + hq * 64;
#pragma unroll
      for (int v = 0; v < 8; ++v) { const v4u w = *(const v4u*)(qp + 8 * v);
#pragma unroll
          for (int e = 0; e < 4; ++e) { q[8 * v + 2 * e] = bflo(w[e]); q[8 * v + 2 * e + 1] = bfhi(w[e]); } }
      if (!isctx) { const int rp = t >> 6, cp = t & 63;
#pragma unroll
          for (int i = 0; i < 16; ++i) { const f32x2 r = rope[rp * 16 + i], c2 = rope[cp * 16 + i];
              const float a = q[i], b = q[i + 16]; q[i] = a * r.x - b * r.y; q[i + 16] = a * r.y + b * r.x;
              const float a2 = q[32 + i], b2 = q[48 + i]; q[32 + i] = a2 * c2.x - b2 * c2.y; q[48 + i] = a2 * c2.y + b2 * c2.x; } }
#pragma unroll
      for (int d = 0; d < 64; ++d) q[d] *= 0.125f; }
    float m = A.in[I_SINK][l * 8 + hq], lsum = 1.f;
    float o[64];
#pragma unroll
    for (int d = 0; d < 64; ++d) o[d] = 0.f;
    for (int kt = isctx ? 3 : 0; kt < 5; ++kt) {
        const int jb = qb - 1 + kt;
        if (kt < 3 && (jb < 0 || jb >= SEQ / 128)) continue;
        const int krow0 = kt < 3 ? bl * SEQ + jb * 128 : HLAT + bl * LCTX + (kt - 3) * 128;
        __syncthreads();
        { const int row = F.tid >> 2, hs = (F.tid >> 1) & 1, sub = F.tid & 1, dlo = hs * 32 + sub * 8;
          const bf16* kp = UR + (size_t)(krow0 + row) * UR_LD + UR_K + kvh * 64 + dlo; const bf16* vp = kp + (UR_V - UR_K);
          const v4u k0 = *(const v4u*)kp, k1 = *(const v4u*)(kp + 16), v0 = *(const v4u*)vp, v1 = *(const v4u*)(vp + 16);
          float ka[8], kb[8];
#pragma unroll
          for (int e = 0; e < 4; ++e) { ka[2 * e] = bflo(k0[e]); ka[2 * e + 1] = bfhi(k0[e]); kb[2 * e] = bflo(k1[e]); kb[2 * e + 1] = bfhi(k1[e]); }
          if (kt < 3) { const int j = jb * 128 + row, pos = hs == 0 ? (j >> 6) : (j & 63);
#pragma unroll
              for (int e = 0; e < 8; ++e) { const f32x2 r = rope[pos * 16 + sub * 8 + e]; const float a = ka[e], b = kb[e]; ka[e] = a * r.x - b * r.y; kb[e] = a * r.y + b * r.x; } }
#pragma unroll
          for (int e = 0; e < 8; ++e) { Ks[row * 64 + dlo + e] = ka[e]; Ks[row * 64 + dlo + 16 + e] = kb[e]; }
#pragma unroll
          for (int e = 0; e < 4; ++e) { Vs[row * 64 + dlo + 2 * e] = bflo(v0[e]); Vs[row * 64 + dlo + 2 * e + 1] = bfhi(v0[e]); Vs[row * 64 + dlo + 16 + 2 * e] = bflo(v1[e]); Vs[row * 64 + dlo + 16 + 2 * e + 1] = bfhi(v1[e]); } }
        __syncthreads();
#pragma unroll 1
        for (int key = 0; key < 128; ++key) {
            float a = 0.f;
#pragma unroll
            for (int v = 0; v < 16; ++v) { const f32x4 k4 = *(const LAS f32x4*)(Ks + key * 64 + 4 * v); a += q[4 * v] * k4.x + q[4 * v + 1] * k4.y + q[4 * v + 2] * k4.z + q[4 * v + 3] * k4.w; }
            if (kt < 3) { const int j = jb * 128 + key, dlt = t - j; if (dlt > 128 || dlt < -128) a = -INFINITY; }
            if (__any(a > m)) { const float mn = fmaxf(m, a), alpha = __expf(m - mn); m = mn; lsum *= alpha;
#pragma unroll
                for (int d = 0; d < 64; ++d) o[d] *= alpha; }
            const float pz = __expf(a - m); lsum += pz;
#pragma unroll
            for (int v = 0; v < 16; ++v) { const f32x4 v4 = *(const LAS f32x4*)(Vs + key * 64 + 4 * v); o[4 * v] += pz * v4.x; o[4 * v + 1] += pz * v4.y; o[4 * v + 2] += pz * v4.z; o[4 * v + 3] += pz * v4.w; }
        }
    }
    const float inv = 1.f / lsum;
    const bf16* zp = UR + (size_t)qrow * UR_LD + UR_ZA + hq * 64;
    bf16* yp = (bf16*)(F.ws + WS_Y) + ((size_t)hf * HROWS + qrow) * Y_LD + 1024 + hq * 64;
#pragma unroll
    for (int v = 0; v < 8; ++v) { const v4u zw = *(const v4u*)(zp + 8 * v); v4u ow;
#pragma unroll
        for (int e = 0; e < 4; ++e) ow[e] = pk2(o[8 * v + 2 * e] * inv * siluf(bflo(zw[e])), o[8 * v + 2 * e + 1] * inv * siluf(bfhi(zw[e])));
        *(v4u*)(yp + 8 * v) = ow; }
}
__device__ __forceinline__ void phase3(Frame& F, const Args& A, int l, int hf, unsigned* ctr) {
    F.refresh();
    for (int it = F.bid; it < 136; it += F.G) ssd_prep_tile(F, A, l, it / 34, it % 34);
    LAS f32x2* buf = (LAS f32x2*)F.lds; LAS f32x2* tw = buf + FFT_BUF_ELEMS;
    LAS float* cks = (LAS float*)(F.lds + 100352); LAS float* csig = cks + 2048;
    LAS float* Ks = (LAS float*)F.lds; LAS float* Vs = Ks + 8192; LAS f32x2* rope = (LAS f32x2*)(Vs + 8192);
    const int n_hy = 1024, n_hc = (l == 0) ? 1024 : 0, n_at = 256, n_ac = (l == 0) ? 16 : 0;
    const int total = n_hy + n_hc + n_at + n_ac;
    bool tw_loaded = false, rope_loaded = false;
    for (;;) {
        int tile = next_tile(F, ctr);
        if (tile >= total) break;
        if (tile < n_hy) { if (!tw_loaded) { load_tw(F, tw); tw_loaded = true; } hyena_tile(F, A, l, hf, tile & 3, tile >> 2, buf, tw); continue; }
        tile -= n_hy;
        if (tile < n_hc) { hyena_ctx_tile(F, A, hf, tile & 3, tile >> 2, cks, csig); continue; }
        tile -= n_hc;
        if (!rope_loaded) { __syncthreads(); const f32x2* gr = (const f32x2*)(F.ws + WS_ROPE); for (int j = F.tid; j < 1024; j += NTHR) rope[j] = gr[j]; rope_loaded = true; __syncthreads(); }
        if (tile < n_at) { attn_tile(F, A, l, hf, tile >> 6, (tile >> 5) & 1, tile & 31, false, Ks, Vs, rope); continue; }
        tile -= n_at;
        attn_tile(F, A, l, hf, tile >> 2, (tile >> 1) & 1, tile & 1, true, Ks, Vs, rope);
    }
    __syncthreads();
}

__device__ __forceinline__ void phase5(Frame& F, const Args& A, int l) {
    F.refresh();
    const int gw = F.bid * NWAVES + F.wave, NGW = F.G * NWAVES;
    const float* T = (const float*)(F.ws + WS_T);
    const float* MOD = (const float*)(F.ws + WS_MOD);
    const float* lg = A.in[I_LNG] + l * 1024; const float* lb = A.in[I_LNB] + l * 1024;
    for (int m = gw; m < MTOT; m += NGW) {
        int islat, b, t; row_map(m, islat, b, t);
        if (l == 1 && !islat) continue;
        f32x4 v[4];
#pragma unroll
        for (int j = 0; j < 4; ++j) v[j] = *((const f32x4*)(T + (size_t)m * DM) + F.lane + 64 * j);
        float mean, rstd; ln_stats(v, mean, rstd, 1e-6f);
#pragma unroll
        for (int j = 0; j < 4; ++j) v[j] = (v[j] - mean) * rstd * *((const f32x4*)lg + F.lane + 64 * j) + *((const f32x4*)lb + F.lane + 64 * j);
        if (islat) { f32x4* o = (f32x4*)(F.out + ((size_t)b * SEQ + t) * DM) + F.lane;
#pragma unroll
            for (int j = 0; j < 4; ++j) o[64 * j] = v[j]; }
        if (l == 0) ln_mod_store(v, MOD + (size_t)(1 * 9 + (islat ? b : 8)) * 3072, (bf16*)(F.ws + WS_XN) + (size_t)m * DM, F.lane);
    }
}

__global__ void __launch_bounds__(NTHR, 2) fwd_megakernel(Args args) {
    extern __shared__ __attribute__((aligned(16))) unsigned char lds_raw[];
    Frame F;
    F.lds = (LAS unsigned char*)lds_raw;
    F.tid = threadIdx.x; F.lane = F.tid & 63; F.wave = __builtin_amdgcn_readfirstlane(F.tid >> 6);
    F.bid = blockIdx.x; F.G = gridDim.x; F.out = args.out; F.ws = args.ws;
    for (int u = F.tid; u < (LDS_BYTES - LDSCTL_OFF) / 4; u += NTHR) ((LAS unsigned*)(F.lds + LDSCTL_OFF))[u] = 0u;
    __syncthreads();
    unsigned* ctl = (unsigned*)(F.ws + WS_CTL);
    XcdBarrier bar = xcd_barrier_post(ctl + CW_BAR, (volatile LAS unsigned*)(F.lds + LDSCTL_OFF));
#define GRID_BAR() xcd_barrier(bar)
    phase0(F, args); GRID_BAR();
    phase1(F, args); GRID_BAR();
    phase1b(F); GRID_BAR();
#pragma unroll
    for (int l = 0; l < 2; ++l) {
#pragma unroll
        for (int hf = 0; hf < 2; ++hf) {
            {
                const pg8::bf16_t* XNh = (const pg8::bf16_t*)(F.ws + WS_XN) + (size_t)hf * HROWS * DM;
                { pg8::Gemm g{(const pg8::bf16_t*)(F.ws + WS_WHY) + (size_t)l * 2048 * 1024, XNh, 2048, HROWS, DM}; pg8::StaticOrder S; S.init(2048, HROWS, F.G, F.bid);
                  pg8::EpiBf16 E{(pg8::bf16_t*)(F.ws + WS_UHY), HROWS};
                  pg8::gemm_phase<pg8::EpiBf16, pg8::StaticOrder, true, true>(F.lds, g, S, E); }
                { pg8::Gemm g{XNh, (const pg8::bf16_t*)(F.ws + WS_WR) + (size_t)l * 3072 * 1024, HROWS, UR_LD, DM}; pg8::StaticOrder S; S.init(HROWS, UR_LD, F.G, F.bid);
                  pg8::EpiBf16 E{(pg8::bf16_t*)(F.ws + WS_UR), UR_LD};
                  pg8::gemm_phase<pg8::EpiBf16, pg8::StaticOrder, true, true>(F.lds, g, S, E); }
            }
            GRID_BAR();
            phase3(F, args, l, hf, ctl + CW_CTR + 64 * (l * 2 + hf)); GRID_BAR();
            for (int it = F.bid; it < 1088; it += F.G) ssd_state_tile(F, it / 272, (it >> 3) % 34, it & 7);
            GRID_BAR();
            ssd_scan(F); GRID_BAR();
            for (int it = F.bid; it < 1088; it += F.G) { const int slot = (it >> 3) % 34; if (l == 1 && slot < 2) continue; ssd_out_tile(F, it / 272, slot, it & 7); }
            GRID_BAR();
            ssd_finish(F, args, l, hf, l == 0 ? HROWS : HLAT); GRID_BAR();
        }
        {
            pg8::Gemm g{(const pg8::bf16_t*)(F.ws + WS_Y), (const pg8::bf16_t*)(F.ws + WS_WO) + (size_t)l * 1024 * 1536, MTOT, DM, 1536};
            pg8::EpiRes E{l == 0 ? args.in[I_X] : F.out, args.in[I_CTX], (const float*)(F.ws + WS_MOD), (float*)(F.ws + WS_T), l};
            if (l == 0) { pg8::StaticOrder S; S.init(MTOT, DM, F.G, F.bid); pg8::gemm_phase<pg8::EpiRes, pg8::StaticOrder, true, true>(F.lds, g, S, E); }
            else { pg8::OrderLat S; S.S.init(2 * HLAT, DM, F.G, F.bid); pg8::gemm_phase<pg8::EpiRes, pg8::OrderLat, true, true>(F.lds, g, S, E); }
        }
        GRID_BAR();
        phase5(F, args, l);
        if (l == 0) GRID_BAR();
    }
}

extern "C" void kernel_launch(void* const* d_in, const int* in_sizes, int n_in, void* d_out, int out_size, void* d_ws, size_t ws_size, hipStream_t stream) {
    static int grid = 0;
    if (grid == 0) {
        if (n_in != 28 || out_size != NBATCH * SEQ * DM || ws_size < WS_END) { fprintf(stderr, "kernel_launch: unexpected problem (n_in %d, out %d, ws %zu); nothing launched\n", n_in, out_size, ws_size); grid = -1; return; }
        int dev = 0, cus = 0, per_cu = 0;
        if (hipGetDevice(&dev) != hipSuccess || hipDeviceGetAttribute(&cus, hipDeviceAttributeMultiprocessorCount, dev) != hipSuccess) { grid = -1; return; }
        if (hipFuncSetAttribute((const void*)fwd_megakernel, hipFuncAttributeMaxDynamicSharedMemorySize, LDS_BYTES) != hipSuccess) { fprintf(stderr, "kernel_launch: hipFuncSetAttribute failed\n"); grid = -1; return; }
        if (hipOccupancyMaxActiveBlocksPerMultiprocessor(&per_cu, (const void*)fwd_megakernel, NTHR, LDS_BYTES) != hipSuccess || per_cu < 1) { fprintf(stderr, "kernel_launch: occupancy query says %d blocks per CU\n", per_cu); grid = -1; return; }
        (void)hipGetLastError();
        grid = cus;
    }
    if (grid < 0) return;
    (void)hipMemsetAsync((char*)d_ws + WS_CTL, 0, CTL_ZERO_BYTES, stream);
    Args a{};
    for (int i = 0; i < 28; ++i) a.in[i] = (const float*)d_in[i];
    a.out = (float*)d_out; a.ws = (unsigned char*)d_ws; a.ph_lo = 0; a.ph_hi = 0;
    void* kargs[] = {&a};
    hipError_t e = hipLaunchCooperativeKernel((const void*)fwd_megakernel, dim3(grid), dim3(NTHR), kargs, LDS_BYTES, stream);
    if (e != hipSuccess) fprintf(stderr, "kernel_launch: cooperative launch failed: %s (grid %d)\n", hipGetErrorString(e), grid);
}
```

```cpp
#include <hip/hip_runtime.h>
#include <cstdio>
#include <cstdint>
namespace pg8 {
#define PG8_LAS __attribute__((address_space(3)))
typedef unsigned short bf16_t;
typedef short bf16x8 __attribute__((ext_vector_type(8)));
typedef float f32x4 __attribute__((ext_vector_type(4)));
typedef unsigned u32x4 __attribute__((ext_vector_type(4)));
constexpr int BM = 256, BK = 64, HALF = 128, HTB = HALF * BK * 2  , STAGE_BYTES = 8 * HTB, NXCD = 8, WGM = 8;

__host__ __device__ __forceinline__ int lds_byte(int r, int c) { const int st = (r >> 4) * 2 + (c >> 5), rr = r & 15, cc = c & 31, ob = rr * 64 + cc * 2; return st * 1024 + (ob ^ (((ob >> 9) & 1) << 5)); }
__host__ __device__ __forceinline__ void stage_rc(int b, int& R, int& C) { const int st = b / 1024, sb = b % 1024, swz = sb ^ (((sb >> 9) & 1) << 5); R = (st >> 1) * 16 + swz / 64; C = (st & 1) * 32 + (swz % 64) / 2; }
__host__ __device__ __forceinline__ int perm32(int rho) { const int n = rho >> 4, i = rho & 15; return 8 * (i >> 2) + 4 * n + (i & 3); }

struct Unit { int pm, pn; };
struct Gemm { const bf16_t* A; const bf16_t* Bt; int M, N, K; };

struct StaticOrder {
    int nM, nN, nwg, G, c;
    __host__ __device__ void init(int M, int N, int G_, int c_) { nM = M / BM; nN = N / BM; nwg = nM * nN; G = G_; c = c_; }
    __host__ __device__ bool next(int i, Unit& u) const {
        const long L = (long)i * G + c; if (L >= nwg) return false;
        int wgid = (int)L; { const int q = nwg / NXCD, r = nwg % NXCD, xcd = wgid % NXCD, off = wgid / NXCD; wgid = (xcd < r ? xcd * (q + 1) : r * (q + 1) + (xcd - r) * q) + off; }
        const int nig = WGM * nN, gid = wgid / nig, fm = gid * WGM, gsz = (nM - fm) < WGM ? (nM - fm) : WGM;
        u.pm = fm + ((wgid % nig) % gsz); u.pn = (wgid % nig) / gsz; return true;
    }
    __device__ __forceinline__ void a_ready(const Unit&) const {}
    __device__ __forceinline__ void done(const Unit&) const {}
};

__device__ __forceinline__ unsigned cvt_pk_bf16(float lo, float hi) { unsigned r; asm volatile("v_cvt_pk_bf16_f32 %0, %1, %2" : "=v"(r) : "v"(lo), "v"(hi)); return r; }
struct EpiBf16 {
    static constexpr bool PERM = true, AFTER_DRAIN = false;
    bf16_t* O; int ldc;
    __device__ __forceinline__ void operator()(const f32x4 (&acc)[2][2][4][2], const Unit& u, int wr, int wc, int fr, int fq) const {
        asm volatile("" : "+v"(fr), "+v"(fq));
        const int row0 = u.pm * BM + wr * 64 + fr; const int col0 = u.pn * BM + wc * 32 + 8 * fq;
#pragma unroll
        for (int ai = 0; ai < 2; ++ai)
#pragma unroll
            for (int m = 0; m < 4; ++m) { bf16_t* rowp = O + (size_t)(row0 + ai * HALF + m * 16) * ldc + col0;
#pragma unroll
                for (int bj = 0; bj < 2; ++bj) { const f32x4 v0 = acc[ai][bj][m][0], v1 = acc[ai][bj][m][1];
                    u32x4 w; w.x = cvt_pk_bf16(v0[0], v0[1]); w.y = cvt_pk_bf16(v0[2], v0[3]); w.z = cvt_pk_bf16(v1[0], v1[1]); w.w = cvt_pk_bf16(v1[2], v1[3]);
                    *(u32x4*)(rowp + bj * HALF) = w; } }
    }
};
struct EpiRes {
    static constexpr bool PERM = false, AFTER_DRAIN = false;
    const float* xlat; const float* xctx; const float* mod; float* T; int layer;
    __device__ __forceinline__ void operator()(const f32x4 (&acc)[2][2][4][2], const Unit& u, int wr, int wc, int fr, int fq) const {
        asm volatile("" : "+v"(fr), "+v"(fq));
        const int pm = u.pm, hf = pm / 68, pr = pm % 68;
        const float* src; const float* gv;
        if (pr < 64) { const int b = hf * 4 + (pr >> 4); src = xlat + ((size_t)b * 4096 + (size_t)(pr & 15) * 256) * 1024; gv = mod + (size_t)(layer * 9 + b) * 3072 + 2048; }
        else { const int b = hf * 4 + (pr - 64); src = xctx + (size_t)b * 256 * 1024; gv = mod + (size_t)(layer * 9 + 8) * 3072 + 2048; }
        const int col0 = u.pn * BM + wc * 32 + 4 * fq;
        const float alpha = 1.41421356237f;
#pragma unroll
        for (int bj = 0; bj < 2; ++bj)
#pragma unroll
            for (int n = 0; n < 2; ++n) { const int col = col0 + bj * HALF + n * 16; const f32x4 g4 = *(const f32x4*)(gv + col);
#pragma unroll
                for (int ai = 0; ai < 2; ++ai)
#pragma unroll
                    for (int m = 0; m < 4; ++m) { const int r = ai * HALF + wr * 64 + m * 16 + fr;
                        const f32x4 xs = *(const f32x4*)(src + (size_t)r * 1024 + col);
                        *(f32x4*)(T + ((size_t)pm * BM + r) * 1024 + col) = xs * alpha + g4 * acc[ai][bj][m][n]; } }
    }
};
struct OrderLat {
    StaticOrder S;
    __device__ __forceinline__ bool next(int i, Unit& u) const { if (!S.next(i, u)) return false; u.pm = (u.pm >> 6) * 68 + (u.pm & 63); return true; }
    __device__ __forceinline__ void a_ready(const Unit&) const {}
    __device__ __forceinline__ void done(const Unit&) const {}
};
template <class Epi, class Sched, bool ALIGN_EPI = false, bool SP2 = false>
__device__ __forceinline__ void gemm_phase(PG8_LAS unsigned char* lds, const Gemm g, const Sched& S, const Epi& E) {
    int tid_ = threadIdx.x; asm volatile("" : "+v"(tid_));
    const int tid = tid_, wid = __builtin_amdgcn_readfirstlane(tid >> 6), lane = tid & 63, wr = wid >> 2, wc = wid & 3, fr = lane & 15, fq = lane >> 4;
    const int K = g.K, nt = K / BK;
    unsigned voffA[2], voffB[2];
#pragma unroll
    for (int i = 0; i < 2; ++i) { int R, C; stage_rc(tid * 16 + i * 8192, R, C); const int Rb = Epi::PERM ? ((R & ~31) + perm32(R & 31)) : R;
        voffA[i] = (unsigned)(R * K + C) * 2u; voffB[i] = (unsigned)(Rb * K + C) * 2u; }
    const size_t kstep = (size_t)(BK * 2);
    const size_t hstep = (size_t)HALF * K * 2;
    const size_t tstep = 2 * hstep;
    const unsigned ldsw = (unsigned)wid * 1024u;
    const int aoff = lds_byte(wr * 64 + fr, fq * 8), boff = lds_byte(wc * 32 + fr, fq * 8);
#define PG8_SA(b, h) (((b) * 2 + (h)) * HTB)
#define PG8_SB(b, h) ((4 + (b) * 2 + (h)) * HTB)
#define PG8_STAGE(bufoff, gbase, voff) do { _Pragma("unroll") for (int _i = 0; _i < 2; ++_i) \
        __builtin_amdgcn_global_load_lds((const unsigned*)((const char*)(gbase) + (voff)[_i]), (PG8_LAS unsigned*)(lds + (bufoff) + ldsw + _i * 8192), 16, 0, 0); } while (0)
#define PG8_LDA(dst, b, h) do { _Pragma("unroll") for (int m = 0; m < 4; ++m) _Pragma("unroll") for (int k = 0; k < 2; ++k) dst[m][k] = *(const PG8_LAS bf16x8*)(lds + PG8_SA(b, h) + aoff + m * 2048 + k * 1024); } while (0)
#define PG8_LDB(dst, b, h) do { _Pragma("unroll") for (int n = 0; n < 2; ++n) _Pragma("unroll") for (int k = 0; k < 2; ++k) dst[n][k] = *(const PG8_LAS bf16x8*)(lds + PG8_SB(b, h) + boff + n * 2048 + k * 1024); } while (0)
#define PG8_MMA(ai, bj, At, Bt) do { __builtin_amdgcn_s_setprio(1); _Pragma("unroll") for (int m = 0; m < 4; ++m) _Pragma("unroll") for (int n = 0; n < 2; ++n) _Pragma("unroll") for (int k = 0; k < 2; ++k) \
        acc[ai][bj][m][n] = __builtin_amdgcn_mfma_f32_16x16x32_bf16(Bt[n][k], At[m][k], acc[ai][bj][m][n], 0, 0, 0); __builtin_amdgcn_s_setprio(0); } while (0)
#define PG8_WAIT_V(n) asm volatile("s_waitcnt vmcnt(" #n ")" ::: "memory")
#define PG8_WAIT_L(n) asm volatile("s_waitcnt lgkmcnt(" #n ")" ::: "memory")
#define PG8_BAR __builtin_amdgcn_s_barrier()
#define PG8_SCHED __builtin_amdgcn_sched_barrier(0)
    Unit cur, nxt; int ui = 0;
    if (!S.next(0, cur)) return;
    f32x4 acc[2][2][4][2];
#pragma unroll
    for (int a = 0; a < 2; ++a)
#pragma unroll
        for (int b = 0; b < 2; ++b)
#pragma unroll
            for (int m = 0; m < 4; ++m)
#pragma unroll
                for (int n = 0; n < 2; ++n) acc[a][b][m][n] = (f32x4){0.f, 0.f, 0.f, 0.f};
    bf16x8 At[4][2], B0[2][2], B1[2][2];
    const char* cA = (const char*)g.A + (size_t)cur.pm * tstep; const char* cB = (const char*)g.Bt + (size_t)cur.pn * tstep;
    S.a_ready(cur);
    if constexpr (SP2) {
        PG8_STAGE(PG8_SB(0, 0), cB, voffB); PG8_STAGE(PG8_SB(0, 1), cB + hstep, voffB); PG8_STAGE(PG8_SA(0, 0), cA, voffA); PG8_STAGE(PG8_SA(0, 1), cA + hstep, voffA);
        if (wr == 1) PG8_BAR;
        PG8_WAIT_V(2); PG8_BAR;
        PG8_STAGE(PG8_SB(1, 0), cB + kstep, voffB); PG8_STAGE(PG8_SA(1, 0), cA + kstep, voffA); PG8_STAGE(PG8_SB(1, 1), cB + hstep + kstep, voffB);
        PG8_WAIT_V(6); PG8_BAR;
    } else {
        PG8_STAGE(PG8_SB(0, 0), cB, voffB); PG8_STAGE(PG8_SA(0, 0), cA, voffA); PG8_STAGE(PG8_SB(0, 1), cB + hstep, voffB); PG8_STAGE(PG8_SA(0, 1), cA + hstep, voffA);
        if (wr == 1) PG8_BAR;
        PG8_WAIT_V(4); PG8_BAR;
        PG8_STAGE(PG8_SB(1, 0), cB + kstep, voffB); PG8_STAGE(PG8_SA(1, 0), cA + kstep, voffA); PG8_STAGE(PG8_SB(1, 1), cB + hstep + kstep, voffB);
        PG8_WAIT_V(6); PG8_BAR;
    }
    for (;;) {
        const bool has_next = S.next(ui + 1, nxt);
        const char* nA = has_next ? (const char*)g.A + (size_t)nxt.pm * tstep : cA; const char* nB = has_next ? (const char*)g.Bt + (size_t)nxt.pn * tstep : cB;
        for (int t = 0; t < nt; t += 2) {
            const bool last = (t == nt - 2);
            const char* a1 = cA + (size_t)(t + 1) * kstep;
            const char* a2 = last ? nA : cA + (size_t)(t + 2) * kstep; const char* b2 = last ? nB : cB + (size_t)(t + 2) * kstep;
            const char* a3 = a2 + kstep; const char* b3 = b2 + kstep;
            if (last && has_next) S.a_ready(nxt);
            if constexpr (SP2) {
            PG8_LDB(B0, 0, 0); PG8_LDB(B1, 0, 1); PG8_SCHED; PG8_LDA(At, 0, 0); PG8_STAGE(PG8_SA(1, 1), a1 + hstep, voffA);
            PG8_WAIT_V(8); PG8_WAIT_L(0); PG8_BAR; PG8_MMA(0, 0, At, B0); PG8_MMA(0, 1, At, B1); PG8_BAR; PG8_SCHED;
            PG8_LDA(At, 0, 1); PG8_STAGE(PG8_SB(0, 0), b2, voffB); PG8_STAGE(PG8_SB(0, 1), b2 + hstep, voffB); PG8_STAGE(PG8_SA(0, 0), a2, voffA);
            PG8_WAIT_V(8); PG8_WAIT_L(0); PG8_BAR; PG8_MMA(1, 0, At, B0); PG8_MMA(1, 1, At, B1); PG8_BAR; PG8_SCHED;
            PG8_LDB(B0, 1, 0); PG8_LDB(B1, 1, 1); PG8_SCHED; PG8_LDA(At, 1, 0); PG8_STAGE(PG8_SA(0, 1), a2 + hstep, voffA);
            PG8_WAIT_V(8); PG8_WAIT_L(0); PG8_BAR; PG8_MMA(0, 0, At, B0); PG8_MMA(0, 1, At, B1); PG8_BAR; PG8_SCHED;
            PG8_LDA(At, 1, 1); PG8_STAGE(PG8_SB(1, 0), b3, voffB); PG8_STAGE(PG8_SB(1, 1), b3 + hstep, voffB); PG8_STAGE(PG8_SA(1, 0), a3, voffA);
            PG8_WAIT_V(8); PG8_WAIT_L(0); PG8_BAR; PG8_MMA(1, 0, At, B0); PG8_MMA(1, 1, At, B1); PG8_BAR; PG8_SCHED;
            } else {
            PG8_LDB(B0, 0, 0); PG8_SCHED; PG8_LDA(At, 0, 0); PG8_STAGE(PG8_SA(1, 1), a1 + hstep, voffA);
            PG8_WAIT_L(8); PG8_BAR; PG8_WAIT_L(0); PG8_MMA(0, 0, At, B0); PG8_BAR; PG8_SCHED;
            PG8_LDB(B1, 0, 1); PG8_STAGE(PG8_SB(0, 0), b2, voffB);
            PG8_BAR; PG8_WAIT_L(0); PG8_MMA(0, 1, At, B1); PG8_BAR;
            PG8_LDA(At, 0, 1); PG8_STAGE(PG8_SA(0, 0), a2, voffA);
            PG8_BAR; PG8_WAIT_L(0); PG8_MMA(1, 0, At, B0); PG8_BAR; PG8_SCHED;
            PG8_STAGE(PG8_SB(0, 1), b2 + hstep, voffB);
            PG8_WAIT_V(6); PG8_BAR; PG8_MMA(1, 1, At, B1); PG8_BAR;
            PG8_LDB(B0, 1, 0); PG8_SCHED; PG8_LDA(At, 1, 0); PG8_STAGE(PG8_SA(0, 1), a2 + hstep, voffA);
            PG8_WAIT_L(8); PG8_BAR; PG8_WAIT_L(0); PG8_MMA(0, 0, At, B0); PG8_BAR; PG8_SCHED;
            PG8_LDB(B1, 1, 1); PG8_STAGE(PG8_SB(1, 0), b3, voffB);
            PG8_BAR; PG8_WAIT_L(0); PG8_MMA(0, 1, At, B1); PG8_BAR;
            PG8_LDA(At, 1, 1); PG8_STAGE(PG8_SA(1, 0), a3, voffA);
            PG8_BAR; PG8_WAIT_L(0); PG8_MMA(1, 0, At, B0); PG8_BAR; PG8_SCHED;
            PG8_STAGE(PG8_SB(1, 1), b3 + hstep, voffB);
            PG8_WAIT_V(6); PG8_BAR; PG8_MMA(1, 1, At, B1); PG8_BAR;
            }
        }
        if constexpr (ALIGN_EPI) { if (wr == 0) PG8_BAR; }
        if constexpr (!Epi::AFTER_DRAIN) { E(acc, cur, wr, wc, fr, fq); S.done(cur); }
        if (!has_next) break;
#pragma unroll
        for (int a = 0; a < 2; ++a)
#pragma unroll
            for (int b = 0; b < 2; ++b)
#pragma unroll
                for (int m = 0; m < 4; ++m)
#pragma unroll
                    for (int n = 0; n < 2; ++n) acc[a][b][m][n] = (f32x4){0.f, 0.f, 0.f, 0.f};
        cur = nxt; cA = nA; cB = nB; ++ui;
        if constexpr (ALIGN_EPI) { if (wr == 1) PG8_BAR; }
    }
    PG8_WAIT_V(0);
    if constexpr (!ALIGN_EPI) { if (wr == 0) PG8_BAR; }
    PG8_BAR;
    if constexpr (Epi::AFTER_DRAIN) { E.fused(acc, cur, wr, wc, fr, fq, lds, wid, lane); S.done(cur); }
#undef PG8_SA
#undef PG8_SB
#undef PG8_STAGE
#undef PG8_LDA
#undef PG8_LDB
#undef PG8_MMA
#undef PG8_WAIT_V
#undef PG8_WAIT_L
#undef PG8_BAR
#undef PG8_SCHED
}
}
constexpr int DM = 1024, NBATCH = 8, SEQ = 4096, LCTX = 256, NIN = 4880;
constexpr int HLAT = 4 * SEQ, HCTX = 4 * LCTX, HROWS = HLAT + HCTX  , MTOT = 2 * HROWS  ;
constexpr int UR_LD = 3072, Y_LD = 1536;
constexpr int UR_Z = 1024, UR_DT = 1536, UR_Q = 1792, UR_K = 2304, UR_V = 2432, UR_ZA = 2560;
constexpr int NWAVES = 8, NTHR = 512;
constexpr size_t MiB = 1u << 20;
constexpr size_t WS_CTL = 0, CTL_ZERO_BYTES = 1 * MiB;
constexpr size_t WS_MOD = 1 * MiB;
constexpr size_t WS_ROPE = 1 * MiB + 256 * 1024;
constexpr size_t WS_TW = 1 * MiB + 512 * 1024;
constexpr size_t WS_H3 = 2 * MiB;
constexpr size_t WS_KC = 5 * MiB;
constexpr size_t WS_WHY = 8 * MiB;
constexpr size_t WS_WR = 16 * MiB;
constexpr size_t WS_WO = 28 * MiB;
constexpr size_t WS_SPEC = 36 * MiB;
constexpr int SPEC_LD = 4104;
constexpr size_t WS_XN = 101 * MiB;
constexpr size_t WS_Y = 169 * MiB;
constexpr size_t WS_UHY = 271 * MiB;
constexpr size_t WS_UR = 339 * MiB;
constexpr size_t WS_T = 271 * MiB;
constexpr size_t WS_KFULL = 271 * MiB;
constexpr size_t WS_XBC = 441 * MiB;
constexpr size_t WS_STATE = 475 * MiB;
constexpr size_t WS_DTA = 509 * MiB;
constexpr size_t WS_YS = WS_XN;
constexpr size_t WS_END = 512 * MiB;
constexpr int CW_BAR = 4096, CW_CTR = 16384;
constexpr int LDS_BYTES = 155648;
constexpr int LDSCTL_OFF = 154624;

#define GAS __attribute__((address_space(1)))
#define LAS __attribute__((address_space(3)))
typedef unsigned short bf16;
typedef unsigned v4u __attribute__((ext_vector_type(4)));
typedef unsigned v2u __attribute__((ext_vector_type(2)));
typedef float f32x4 __attribute__((ext_vector_type(4)));
typedef float f32x2 __attribute__((ext_vector_type(2)));
#define LDS_WAIT() asm volatile("s_waitcnt lgkmcnt(0)" ::: "memory")
__device__ __forceinline__ unsigned f2bf(float f) { unsigned u = __builtin_bit_cast(unsigned, f); return (u + 0x7fffu + ((u >> 16) & 1u)) >> 16; }
__device__ __forceinline__ unsigned pk2(float lo, float hi) { return f2bf(lo) | (f2bf(hi) << 16); }
__device__ __forceinline__ float bf2f(unsigned short h) { return __builtin_bit_cast(float, (unsigned)h << 16); }
__device__ __forceinline__ float bflo(unsigned w) { return __builtin_bit_cast(float, w << 16); }
__device__ __forceinline__ float bfhi(unsigned w) { return __builtin_bit_cast(float, w & 0xffff0000u); }
__device__ __forceinline__ float siluf(float x) { return x / (1.f + __expf(-x)); }
__device__ __forceinline__ float wave_sum(float v) {
#pragma unroll
    for (int o = 1; o < 64; o <<= 1) v += __shfl_xor(v, o);
    return v;
}

#define XB_TMO      128
#define XB_XCNT(j)  (256  + 64 * (j))
#define XB_XSUB(j)  (1280 + 64 * (j))
#define XB_XGEN(j)  (2304 + 64 * (j))
#define XB_TOP      3328
#define XB_TOPGEN   3392
#define XCD_BAR_WORDS 3456
#define XB_SPIN_CAP (1u << 22)
__device__ __forceinline__ unsigned xb_ld(unsigned* p)              { return __hip_atomic_load(p, __ATOMIC_RELAXED, __HIP_MEMORY_SCOPE_AGENT); }
__device__ __forceinline__ unsigned xb_add(unsigned* p, unsigned v) { return __hip_atomic_fetch_add(p, v, __ATOMIC_RELAXED, __HIP_MEMORY_SCOPE_AGENT); }
__device__ __forceinline__ unsigned xb_xcc_id() { return (unsigned)__builtin_amdgcn_s_getreg((3 << 11) | 20) & 0xFu; }
#define XB_SPIN(cond, bar) do { unsigned _sp = 0; while (cond) { __builtin_amdgcn_s_sleep(1); \
    if ((++_sp & 255u) == 0u) { if (xb_ld(&(bar)[XB_TMO])) break; if (_sp > XB_SPIN_CAP) { atomicAdd(&(bar)[XB_TMO], 1u); break; } } } } while (0)
struct XcdBarrier { unsigned* bar; unsigned x; volatile LAS unsigned* st; };
__device__ __forceinline__ XcdBarrier xcd_barrier_post(unsigned* bar, volatile LAS unsigned* st) {
    XcdBarrier b; b.bar = bar; b.x = xb_xcc_id(); b.st = st;
    if (threadIdx.x == 0) (void)xb_add(&bar[XB_XCNT(b.x)], 1u);
    return b;
}
__device__ __forceinline__ void xcd_barrier_complete(unsigned* bar, unsigned x, unsigned& nloc, unsigned& nx) {
    const unsigned G = gridDim.x * gridDim.y * gridDim.z;
    unsigned sum, cnt, mine, sp = 0u;
    for (;;) {
        sum = 0u; cnt = 0u; mine = 0u;
#pragma unroll
        for (unsigned j = 0; j < 16; ++j) { const unsigned c = xb_ld(&bar[XB_XCNT(j)]); sum += c; cnt += (c > 0u) ? 1u : 0u; mine = (j == x) ? c : mine; }
        if (sum == G) break;
        __builtin_amdgcn_s_sleep(1);
        if ((++sp & 255u) == 0u) { if (xb_ld(&bar[XB_TMO])) break; if (sp > XB_SPIN_CAP) { atomicAdd(&bar[XB_TMO], 1u); break; } }
    }
    nloc = mine > 0u ? mine : 1u; nx = cnt > 0u ? cnt : 1u;
}
__device__ __forceinline__ void xcd_barrier(const XcdBarrier& b) {
    asm volatile("s_waitcnt vmcnt(0)" ::: "memory");
    __syncthreads();
    if (threadIdx.x == 0) {
        unsigned* bar = b.bar;
        __builtin_amdgcn_s_waitcnt(0);
        const unsigned bx = xb_xcc_id();
        unsigned nloc = b.st[0], nx = b.st[1];
        if (nloc == 0u) { xcd_barrier_complete(bar, bx, nloc, nx); b.st[0] = nloc; b.st[1] = nx; }
        const unsigned old = xb_add(&bar[XB_XSUB(bx)], 1u);
        const unsigned gen = old / nloc;
        if (old + 1u == (gen + 1u) * nloc) {
            __builtin_amdgcn_fence(__ATOMIC_RELEASE, "agent");
            asm volatile("s_waitcnt vmcnt(0)" ::: "memory");
            const unsigned og = xb_add(&bar[XB_TOP], 1u);
            const unsigned tg = og / nx;
            if (og + 1u == (tg + 1u) * nx) xb_add(&bar[XB_TOPGEN], 1u);
            else XB_SPIN(xb_ld(&bar[XB_TOPGEN]) == tg, bar);
            __builtin_amdgcn_fence(__ATOMIC_ACQUIRE, "agent");
            xb_add(&bar[XB_XGEN(bx)], 1u);
            asm volatile("s_waitcnt vmcnt(0)" ::: "memory");
        } else {
            XB_SPIN(xb_ld(&bar[XB_XGEN(bx)]) == gen, bar);
            __builtin_amdgcn_fence(__ATOMIC_ACQUIRE, "agent");
            asm volatile("s_waitcnt vmcnt(0)" ::: "memory");
        }
    }
    __syncthreads();
}

struct Args { const float* in[28]; float* out; unsigned char* ws; int ph_lo, ph_hi; };
enum { I_X = 0, I_C, I_CTX, I_CCTX, I_WMOD, I_BMOD, I_WIN, I_HCW, I_HCB, I_FW1, I_FB1, I_FW2, I_FB2, I_FW3, I_FB3, I_FFREQ, I_FWOUT, I_HBIAS,
       I_SCW, I_SCB, I_DTB, I_ALOG, I_SD, I_SNW, I_SINK, I_WOUT, I_LNG, I_LNB };
struct Frame {
    LAS unsigned char* lds; int tid, lane, wave, bid, G;
    float* out; unsigned char* ws;
    __device__ __forceinline__ void refresh() {
        int t = threadIdx.x; asm volatile("" : "+v"(t)); tid = t; lane = t & 63; wave = __builtin_amdgcn_readfirstlane(t >> 6);
    }
};
__device__ __forceinline__ int next_tile(Frame& F, unsigned* ctr) {
    volatile LAS int* slot = (volatile LAS int*)(F.lds + LDSCTL_OFF + 64);
    __syncthreads();
    if (F.tid == 0) *slot = (int)atomicAdd(ctr, 1u);
    __syncthreads();
    return *slot;
}

__device__ __forceinline__ void p0_transpose_item(const float* W, int ldw, int K, int nblk, bf16* WT, int mode, LAS float* scr, int item, int lane) {
    const int kb = item / nblk, nb = item % nblk, k0 = 64 * kb, n0 = 32 * nb;
    const int r = n0 + (lane & 31);
    int src = r;
    if (mode == 1) src = (r < 1552) ? (2048 + r) : (r < 1792 ? -1 : 3600 + (r - 1792));
#pragma unroll 8
    for (int i = 0; i < 32; ++i) { const int kk = 2 * i + (lane >> 5); scr[kk * 33 + (lane & 31)] = (src >= 0) ? W[(size_t)(k0 + kk) * ldw + src] : 0.f; }
    LDS_WAIT(); asm volatile("" ::: "memory");
    const int c = lane & 7;
#pragma unroll
    for (int j = 0; j < 4; ++j) { const int n = (lane >> 3) + 8 * j; const LAS float* s = scr + (8 * c) * 33 + n;
        v4u o; o.x = pk2(s[0 * 33], s[1 * 33]); o.y = pk2(s[2 * 33], s[3 * 33]); o.z = pk2(s[4 * 33], s[5 * 33]); o.w = pk2(s[6 * 33], s[7 * 33]);
        *(v4u*)(WT + (size_t)(n0 + n) * K + k0 + 8 * c) = o; }
    LDS_WAIT(); asm volatile("" ::: "memory");
}
__device__ __forceinline__ void phase0(Frame& F, const Args& A) {
    F.refresh();
    const int gw = F.bid * NWAVES + F.wave, NGW = F.G * NWAVES;
    {
        LAS float* scr = (LAS float*)(F.lds + F.wave * 16384);
        constexpr int I_HY = 16 * 64, I_R = 16 * 96, I_O = 24 * 32, I_L = I_HY + I_R + I_O;
        for (int it = gw; it < 2 * I_L; it += NGW) {
            const int l = it / I_L; int r = it % I_L;
            const float* win = A.in[I_WIN] + (size_t)l * 1024 * NIN;
            if (r < I_HY) { p0_transpose_item(win, NIN, 1024, 64, (bf16*)(F.ws + WS_WHY) + (size_t)l * 2048 * 1024, 0, scr, r, F.lane); continue; } r -= I_HY;
            if (r < I_R) { p0_transpose_item(win, NIN, 1024, 96, (bf16*)(F.ws + WS_WR) + (size_t)l * 3072 * 1024, 1, scr, r, F.lane); continue; } r -= I_R;
            p0_transpose_item(A.in[I_WOUT] + (size_t)l * 1536 * 1024, 1024, 1536, 32, (bf16*)(F.ws + WS_WO) + (size_t)l * 1024 * 1536, 0, scr, r, F.lane);
        }
    }
    __syncthreads();
    {
        float* tw = (float*)(F.ws + WS_TW); float* rope = (float*)(F.ws + WS_ROPE);
        for (int j = F.bid * NTHR + F.tid; j < 4096; j += F.G * NTHR) { float s, c; sincospif((float)j * (1.0f / 4096.0f), &s, &c); tw[2 * j] = c; tw[2 * j + 1] = -s; }
        for (int j = F.bid * NTHR + F.tid; j < 1024; j += F.G * NTHR) { const int pos = j >> 4, i = j & 15;
            const float inv = exp2f(-(float)i * (13.287712379549449f / 16.0f)); const float ang = (float)pos * inv;
            rope[2 * j] = cosf(ang); rope[2 * j + 1] = sinf(ang); }
    }
    {
        LAS float* red = (LAS float*)F.lds;
        float* MOD = (float*)(F.ws + WS_MOD);
        for (int it = F.bid; it < 96; it += F.G) {
            const int l = it / 48, j0 = (it % 48) * 64, j = j0 + F.lane;
            float acc[9];
#pragma unroll
            for (int v = 0; v < 9; ++v) acc[v] = 0.f;
            const float* wm = A.in[I_WMOD] + (size_t)l * 1024 * 3072;
            for (int k = F.wave * 128; k < F.wave * 128 + 128; ++k) {
                const float w = wm[(size_t)k * 3072 + j];
#pragma unroll
                for (int v = 0; v < 9; ++v) { const float cv = (v < 8) ? A.in[I_C][v * 1024 + k] : A.in[I_CCTX][k]; acc[v] += siluf(cv) * w; }
            }
            __syncthreads();
#pragma unroll
            for (int v = 0; v < 9; ++v) red[(F.wave * 9 + v) * 64 + F.lane] = acc[v];
            __syncthreads();
            for (int idx = F.tid; idx < 576; idx += NTHR) { const int v = idx >> 6, ln = idx & 63; float s = A.in[I_BMOD][l * 3072 + j0 + ln];
#pragma unroll
                for (int w = 0; w < 8; ++w) s += red[(w * 9 + v) * 64 + ln];
                MOD[(size_t)(l * 9 + v) * 3072 + j0 + ln] = s; }
            __syncthreads();
        }
    }
    {
        LAS float* zs = (LAS float*)F.lds;
        LAS float* ha = zs + 512; LAS float* hb = ha + 512;
        float* H3 = (float*)(F.ws + WS_H3);
        for (int it = F.bid; it < 1088; it += F.G) {
            const int l = it / 544, tt0 = (it % 544) * 8, ti = F.tid >> 6, j = F.tid & 63, tt = tt0 + ti;
            const int L = tt < 4096 ? 4096 : 256, t = tt < 4096 ? tt : tt - 4096;
            __syncthreads();
            if (j < 33) {
                float z;
                if (j == 0) z = (float)t / (float)(L - 1);
                else { const int i = (j - 1) & 15; const float f = 1e-4f + (float)i * ((15.0f - 1e-4f) / 15.0f);
                    float rev = f * (float)t / (float)L; rev -= floorf(rev); float s, c; sincospif(2.0f * rev, &s, &c); z = (j <= 16) ? c : -s; }
                zs[ti * 64 + j] = z;
            }
            __syncthreads();
            const float fr = A.in[I_FFREQ][l * 64 + j];
            { float a = A.in[I_FB1][l * 64 + j]; const float* w1 = A.in[I_FW1] + l * 33 * 64;
              for (int i = 0; i < 33; ++i) a += zs[ti * 64 + i] * w1[i * 64 + j];
              ha[ti * 64 + j] = sinf(fr * a); }
            __syncthreads();
            { float a = A.in[I_FB2][l * 64 + j]; const float* w2 = A.in[I_FW2] + l * 64 * 64;
              for (int i = 0; i < 64; ++i) a += ha[ti * 64 + i] * w2[i * 64 + j];
              hb[ti * 64 + j] = sinf(fr * a); }
            __syncthreads();
            { float a = A.in[I_FB3][l * 64 + j]; const float* w3 = A.in[I_FW3] + l * 64 * 64;
              for (int i = 0; i < 64; ++i) a += hb[ti * 64 + i] * w3[i * 64 + j];
              H3[((size_t)l * 4352 + tt) * 64 + j] = sinf(fr * a); }
        }
        __syncthreads();
    }
}

__device__ __forceinline__ void ln_stats(const f32x4 (&v)[4], float& mean, float& rstd, float eps) {
    float s = 0.f;
#pragma unroll
    for (int j = 0; j < 4; ++j) s += (v[j].x + v[j].y) + (v[j].z + v[j].w);
    mean = wave_sum(s) * (1.f / 1024.f); float s2 = 0.f;
#pragma unroll
    for (int j = 0; j < 4; ++j) { const f32x4 d = v[j] - mean; s2 += (d.x * d.x + d.y * d.y) + (d.z * d.z + d.w * d.w); }
    rstd = 1.f / sqrtf(wave_sum(s2) * (1.f / 1024.f) + eps);
}
__device__ __forceinline__ void ln_mod_store(const f32x4 (&v)[4], const float* modv, bf16* orow, int lane) {
    float mean, rstd; ln_stats(v, mean, rstd, 1e-6f);
    unsigned long long* o8 = (unsigned long long*)orow + lane;
#pragma unroll
    for (int j = 0; j < 4; ++j) { const f32x4 sh = *((const f32x4*)modv + lane + 64 * j), sc = *((const f32x4*)(modv + 1024) + lane + 64 * j);
        const f32x4 y = (v[j] - mean) * rstd * (1.f + sc) + sh;
        o8[64 * j] = (unsigned long long)pk2(y.x, y.y) | ((unsigned long long)pk2(y.z, y.w) << 32); }
}
__device__ __forceinline__ void row_map(int m, int& islat, int& b, int& t) {
    const int hf = m / HROWS, r = m % HROWS;
    if (r < HLAT) { islat = 1; b = hf * 4 + (r >> 12); t = r & 4095; }
    else { islat = 0; const int rc = r - HLAT; b = hf * 4 + (rc >> 8); t = rc & 255; }
}

__device__ __forceinline__ void phase1(Frame& F, const Args& A) {
    F.refresh();
    const int gw = F.bid * NWAVES + F.wave, NGW = F.G * NWAVES;
    const float* MOD = (const float*)(F.ws + WS_MOD);
    bf16* XN = (bf16*)(F.ws + WS_XN);
    for (int m = gw; m < MTOT; m += NGW) {
        int islat, b, t; row_map(m, islat, b, t);
        const float* src = islat ? A.in[I_X] + ((size_t)b * SEQ + t) * DM : A.in[I_CTX] + ((size_t)b * LCTX + t) * DM;
        const float* modv = MOD + (size_t)(0 * 9 + (islat ? b : 8)) * 3072;
        f32x4 v[4];
#pragma unroll
        for (int j = 0; j < 4; ++j) v[j] = *((const f32x4*)src + F.lane + 64 * j);
        ln_mod_store(v, modv, XN + (size_t)m * DM, F.lane);
    }
    {
        LAS float* hs = (LAS float*)F.lds;
        const float* H3 = (const float*)(F.ws + WS_H3);
        const float min_decay = -3.0701134573253945f, max_decay = -15.350567286626973f;
        for (int it = F.bid; it < 528; it += F.G) {
            int l, g; if (it < 272) { l = 0; g = it; } else { l = 1; g = it - 272; }
            int L, t0, N2; const float* hbase; float* dst;
            if (g < 256) { L = 4096; t0 = g * 16; N2 = 8192; hbase = H3 + ((size_t)l * 4352 + t0) * 64; dst = (float*)(F.ws + WS_KFULL) + (size_t)l * 2 * 512 * 8192; }
            else { L = 256; t0 = (g - 256) * 16; N2 = 512; hbase = H3 + ((size_t)l * 4352 + 4096 + t0) * 64; dst = (float*)(F.ws + WS_KC); }
            __syncthreads();
            hs[F.tid] = hbase[F.tid]; hs[F.tid + 512] = hbase[F.tid + 512];
            __syncthreads();
            const int c = F.tid;
            const float absd = fabsf(min_decay + (float)c * ((max_decay - min_decay) / 511.0f));
            for (int conv = 0; conv < 2; ++conv) {
                const float* wo = A.in[I_FWOUT] + (size_t)l * 64 * 2048 + conv * 1024 + c;
                float af[16], ab[16];
#pragma unroll
                for (int i = 0; i < 16; ++i) { af[i] = 0.f; ab[i] = 0.f; }
                for (int k = 0; k < 64; ++k) { const float wf = wo[(size_t)k * 2048], wb = wo[(size_t)k * 2048 + 512];
#pragma unroll
                    for (int i = 0; i < 16; ++i) { const float h = hs[i * 64 + k]; af[i] += h * wf; ab[i] += h * wb; } }
#pragma unroll
                for (int i = 0; i < 16; ++i) { const float win = __expf(-((float)(t0 + i) / (float)(L - 1)) * absd); af[i] *= win; ab[i] *= win; }
                float* row = dst + (size_t)(conv * 512 + c) * N2;
                if (t0 == 0) { af[0] += ab[0]; row[L] = 0.f; }
#pragma unroll
                for (int q = 0; q < 4; ++q) *(f32x4*)(row + t0 + 4 * q) = (f32x4){af[4 * q], af[4 * q + 1], af[4 * q + 2], af[4 * q + 3]};
#pragma unroll
                for (int i = 0; i < 16; ++i) { const int t = t0 + i; if (t >= 1) row[N2 - t] = ab[i]; }
            }
        }
        __syncthreads();
    }
}

__device__ __forceinline__ int padi(int i) { return i + (i >> 5); }
constexpr int FFT_BUF_ELEMS = 8192 + 256;
__device__ __forceinline__ f32x2 cmul(f32x2 a, f32x2 w) { return (f32x2){a.x * w.x - a.y * w.y, a.x * w.y + a.y * w.x}; }
__device__ __forceinline__ f32x2 cmulc(f32x2 a, f32x2 w) { return (f32x2){a.x * w.x + a.y * w.y, a.y * w.x - a.x * w.y}; }
__device__ constexpr float COS32[16] = {1.0f, 0.98078528040323043f, 0.92387953251128674f, 0.83146961230254524f, 0.70710678118654757f, 0.55557023301960229f, 0.38268343236508984f, 0.19509032201612833f,
                                        0.0f, -0.19509032201612819f, -0.38268343236508973f, -0.55557023301960196f, -0.70710678118654746f, -0.83146961230254535f, -0.92387953251128674f, -0.98078528040323043f};
__device__ constexpr float SIN32[16] = {0.0f, 0.19509032201612825f, 0.38268343236508978f, 0.55557023301960218f, 0.70710678118654746f, 0.83146961230254524f, 0.92387953251128674f, 0.98078528040323043f,
                                        1.0f, 0.98078528040323043f, 0.92387953251128674f, 0.83146961230254546f, 0.70710678118654757f, 0.55557023301960218f, 0.38268343236508989f, 0.19509032201612861f};
__host__ __device__ constexpr int brevk(int q, int k) { int r = 0; for (int i = 0; i < k; ++i) r |= ((q >> i) & 1) << (k - 1 - i); return r; }
template <int R> __device__ __forceinline__ void dif_reg(f32x2 (&x)[R]) {
#pragma unroll
    for (int s = R; s >= 2; s >>= 1) {
#pragma unroll
        for (int blk = 0; blk < R; blk += s) {
#pragma unroll
            for (int p = 0; p < s / 2; ++p) {
                const f32x2 a = x[blk + p], b = x[blk + p + s / 2];
                x[blk + p] = a + b;
                const f32x2 d = a - b;
                const int e = p * (32 / s);
                if (e == 0) x[blk + p + s / 2] = d;
                else if (e == 8) x[blk + p + s / 2] = (f32x2){d.y, -d.x};
                else x[blk + p + s / 2] = (f32x2){d.x * COS32[e] + d.y * SIN32[e], d.y * COS32[e] - d.x * SIN32[e]};
            }
        }
    }
}
template <int R> __device__ __forceinline__ void dit_reg(f32x2 (&x)[R]) {
#pragma unroll
    for (int s = 2; s <= R; s <<= 1) {
#pragma unroll
        for (int blk = 0; blk < R; blk += s) {
#pragma unroll
            for (int p = 0; p < s / 2; ++p) {
                const f32x2 A = x[blk + p], b = x[blk + p + s / 2];
                const int e = p * (32 / s);
                f32x2 B;
                if (e == 0) B = b;
                else if (e == 8) B = (f32x2){-b.y, b.x};
                else B = (f32x2){b.x * COS32[e] - b.y * SIN32[e], b.y * COS32[e] + b.x * SIN32[e]};
                x[blk + p] = A + B; x[blk + p + s / 2] = A - B;
            }
        }
    }
}
template <int K, bool INV> __device__ __forceinline__ void fft_pass(LAS f32x2* buf, const LAS f32x2* tw, int n, int lgst, int tid) {
    constexpr int R = 1 << K;
    const int st = 1 << lgst;
    for (int bf = tid; bf < (8192 >> K); bf += NTHR) {
        const int j = bf & (st - 1), base = (bf >> lgst) * n + j;
        f32x2 x[R];
#pragma unroll
        for (int q = 0; q < R; ++q) x[q] = buf[padi(base + q * st)];
        if (!INV) {
            dif_reg<R>(x);
            if (st > 1) { const f32x2 w1 = tw[j * (8192 / n)]; f32x2 w = w1;
#pragma unroll
                for (int r = 1; r < R; ++r) { x[brevk(r, K)] = cmul(x[brevk(r, K)], w); if (r + 1 < R) w = cmul(w, w1); } }
        } else {
            if (st > 1) { const f32x2 w1 = tw[j * (8192 / n)]; f32x2 w = w1;
#pragma unroll
                for (int r = 1; r < R; ++r) { x[brevk(r, K)] = cmulc(x[brevk(r, K)], w); if (r + 1 < R) w = cmul(w, w1); } }
            dit_reg<R>(x);
        }
#pragma unroll
        for (int q = 0; q < R; ++q) buf[padi(base + q * st)] = x[q];
    }
}
__device__ __forceinline__ void fft_fwd(LAS f32x2* buf, const LAS f32x2* tw, int tid) {
    __syncthreads(); fft_pass<4, false>(buf, tw, 8192, 9, tid);
    __syncthreads(); fft_pass<4, false>(buf, tw, 512, 5, tid);
    __syncthreads(); fft_pass<5, false>(buf, tw, 32, 0, tid);
    __syncthreads();
}
__device__ __forceinline__ void fft_inv(LAS f32x2* buf, const LAS f32x2* tw, int tid) {
    __syncthreads(); fft_pass<5, true>(buf, tw, 32, 0, tid);
    __syncthreads(); fft_pass<4, true>(buf, tw, 512, 5, tid);
    __syncthreads(); fft_pass<4, true>(buf, tw, 8192, 9, tid);
    __syncthreads();
}
__device__ __forceinline__ int brev13(int k) { return (int)(__brev((unsigned)k) >> 19); }
__device__ __forceinline__ void load_tw(Frame& F, LAS f32x2* tw) {
    const f32x2* g = (const f32x2*)(F.ws + WS_TW);
    for (int j = F.tid; j < 4096; j += NTHR) tw[j] = g[j];
}

__device__ __forceinline__ void phase1b(Frame& F) {
    F.refresh();
    LAS f32x2* buf = (LAS f32x2*)F.lds; LAS f32x2* tw = buf + FFT_BUF_ELEMS;
    load_tw(F, tw);
    for (int it = F.bid; it < 1024; it += F.G) {
        const int l = it >> 9, conv = (it >> 8) & 1, pair = it & 255;
        const float* ka = (const float*)(F.ws + WS_KFULL) + ((size_t)(l * 2 + conv) * 512 + 2 * pair) * 8192; const float* kb = ka + 8192;
        __syncthreads();
        for (int i = F.tid; i < 8192; i += NTHR) buf[padi(i)] = (f32x2){ka[i], kb[i]};
        fft_fwd(buf, tw, F.tid);
        f32x4* sp = (f32x4*)(F.ws + WS_SPEC) + (size_t)it * SPEC_LD;
        const float sc = 1.0f / (4.0f * 8192.0f);
        for (int k = F.tid; k <= 4096; k += NTHR) {
            const int kn = (8192 - k) & 8191; const f32x2 zk = buf[padi(brev13(k))], zn = buf[padi(brev13(kn))];
            const f32x2 A = (f32x2){zk.x + zn.x, zk.y - zn.y}, D = (f32x2){zk.x - zn.x, zk.y + zn.y};
            const f32x2 Bk = (f32x2){D.y, -D.x};
            sp[k] = (f32x4){(A.x + Bk.x) * sc, (A.y + Bk.y) * sc, (A.x - Bk.x) * sc, (A.y - Bk.y) * sc};
        }
    }
    __syncthreads();
}

__device__ __forceinline__ float conv3(const bf16* row, int t, int Ls, float w0, float w1, float w2, float b) {
    const float u0 = t > 0 ? bf2f(row[t - 1]) : 0.f, u1 = bf2f(row[t]), u2 = t < Ls - 1 ? bf2f(row[t + 1]) : 0.f;
    return w0 * u0 + w1 * u1 + w2 * u2 + b;
}
__device__ __forceinline__ void pointwise_spec(LAS f32x2* buf, const f32x4* sp, int tid) {
    for (int k = tid; k <= 4096; k += NTHR) {
        const int kn = (8192 - k) & 8191, p = padi(brev13(k)), pn = padi(brev13(kn));
        const f32x4 s = sp[k]; const f32x2 P = (f32x2){s.x, s.y}, M = (f32x2){s.z, s.w};
        const f32x2 zk = buf[p], zn = buf[pn];
        const f32x2 znc = (f32x2){zn.x, -zn.y}, zkc = (f32x2){zk.x, -zk.y};
        const f32x2 yk = cmul(zk, P) + cmul(znc, M);
        const f32x2 yn = cmulc(zn, P) + cmulc(zkc, M);
        buf[p] = yk; if (pn != p) buf[pn] = yn;
    }
}
__device__ __forceinline__ void hyena_tile(Frame& F, const Args& A, int l, int hf, int bl, int pair, LAS f32x2* buf, const LAS f32x2* tw) {
    F.refresh();
    const bf16* U = (const bf16*)(F.ws + WS_UHY) + (size_t)bl * SEQ;
    const int c0 = 2 * pair;
    const float* cw = A.in[I_HCW] + (size_t)l * 3 * 1536; const float* cb = A.in[I_HCB] + (size_t)l * 1536;
    float w[3][2][3], bb[3][2];
#pragma unroll
    for (int s = 0; s < 3; ++s)
#pragma unroll
        for (int ch = 0; ch < 2; ++ch) { const int col = s * 512 + c0 + ch; bb[s][ch] = cb[col];
#pragma unroll
            for (int j = 0; j < 3; ++j) w[s][ch][j] = cw[j * 1536 + col]; }
    const float hb0a = A.in[I_HBIAS][(l * 2 + 0) * 512 + c0], hb0b = A.in[I_HBIAS][(l * 2 + 0) * 512 + c0 + 1];
    const float hb1a = A.in[I_HBIAS][(l * 2 + 1) * 512 + c0], hb1b = A.in[I_HBIAS][(l * 2 + 1) * 512 + c0 + 1];
    const bf16* rv0 = U + (size_t)(c0) * HROWS; const bf16* rv1 = rv0 + HROWS;
    const bf16* r10 = U + (size_t)(512 + c0) * HROWS; const bf16* r11 = r10 + HROWS;
    const bf16* r20 = U + (size_t)(1024 + c0) * HROWS; const bf16* r21 = r20 + HROWS;
    const bf16* rg0 = U + (size_t)(1536 + c0) * HROWS; const bf16* rg1 = rg0 + HROWS;
    const f32x4* sp0 = (const f32x4*)(F.ws + WS_SPEC) + (size_t)((l * 2 + 0) * 256 + pair) * SPEC_LD;
    const f32x4* sp1 = (const f32x4*)(F.ws + WS_SPEC) + (size_t)((l * 2 + 1) * 256 + pair) * SPEC_LD;
    __syncthreads();
#pragma unroll
    for (int i = 0; i < 8; ++i) { const int t = F.tid + NTHR * i;
        const float va = conv3(rv0, t, SEQ, w[0][0][0], w[0][0][1], w[0][0][2], bb[0][0]), vb = conv3(rv1, t, SEQ, w[0][1][0], w[0][1][1], w[0][1][2], bb[0][1]);
        buf[padi(t)] = (f32x2){va, vb}; buf[padi(t + 4096)] = (f32x2){0.f, 0.f}; }
    fft_fwd(buf, tw, F.tid); pointwise_spec(buf, sp0, F.tid); fft_inv(buf, tw, F.tid);
    f32x2 y1r[8];
#pragma unroll
    for (int i = 0; i < 8; ++i) { const int t = F.tid + NTHR * i;
        const f32x2 cv = buf[padi(t)];
        const float va = conv3(rv0, t, SEQ, w[0][0][0], w[0][0][1], w[0][0][2], bb[0][0]), vb = conv3(rv1, t, SEQ, w[0][1][0], w[0][1][1], w[0][1][2], bb[0][1]);
        const float xa = conv3(r10, t, SEQ, w[1][0][0], w[1][0][1], w[1][0][2], bb[1][0]), xb = conv3(r11, t, SEQ, w[1][1][0], w[1][1][1], w[1][1][2], bb[1][1]);
        y1r[i] = (f32x2){xa * (cv.x + va * hb0a), xb * (cv.y + vb * hb0b)};
        buf[padi(t)] = y1r[i]; buf[padi(t + 4096)] = (f32x2){0.f, 0.f}; }
    fft_fwd(buf, tw, F.tid); pointwise_spec(buf, sp1, F.tid); fft_inv(buf, tw, F.tid);
    bf16* Y = (bf16*)(F.ws + WS_Y) + ((size_t)hf * HROWS + (size_t)bl * SEQ) * Y_LD + c0;
#pragma unroll
    for (int i = 0; i < 8; ++i) { const int t = F.tid + NTHR * i;
        const f32x2 cv = buf[padi(t)];
        const float xa = conv3(r20, t, SEQ, w[2][0][0], w[2][0][1], w[2][0][2], bb[2][0]), xb = conv3(r21, t, SEQ, w[2][1][0], w[2][1][1], w[2][1][2], bb[2][1]);
        const float ga = bf2f(rg0[t]), gb = bf2f(rg1[t]);
        const float oa = xa * (cv.x + y1r[i].x * hb1a) * siluf(ga), ob = xb * (cv.y + y1r[i].y * hb1b) * siluf(gb);
        *(unsigned*)(Y + (size_t)t * Y_LD) = pk2(oa, ob); }
}
__device__ __forceinline__ void hyena_ctx_tile(Frame& F, const Args& A, int hf, int bl, int pair, LAS float* ks  , LAS float* sig  ) {
    F.refresh();
    const int l = 0;
    const bf16* U = (const bf16*)(F.ws + WS_UHY) + HLAT + (size_t)bl * LCTX;
    const int ch = F.tid >> 8, t = F.tid & 255, c = 2 * pair + ch;
    const float* cw = A.in[I_HCW] + (size_t)l * 3 * 1536; const float* cb = A.in[I_HCB] + (size_t)l * 1536;
    const float* KC = (const float*)(F.ws + WS_KC);
    __syncthreads();
    for (int idx = F.tid; idx < 2048; idx += NTHR) { const int conv = idx >> 10, chh = (idx >> 9) & 1, i = idx & 511; ks[idx] = KC[(size_t)(conv * 512 + 2 * pair + chh) * 512 + i]; }
    const float vc = conv3(U + (size_t)c * HROWS, t, LCTX, cw[c], cw[1536 + c], cw[3072 + c], cb[c]);
    sig[ch * 256 + t] = vc;
    __syncthreads();
    float acc = 0.f;
    for (int s = 0; s < 256; ++s) acc += ks[(0 * 2 + ch) * 512 + ((t - s) & 511)] * sig[ch * 256 + s];
    const float x1 = conv3(U + (size_t)(512 + c) * HROWS, t, LCTX, cw[512 + c], cw[1536 + 512 + c], cw[3072 + 512 + c], cb[512 + c]);
    const float y1 = x1 * (acc + vc * A.in[I_HBIAS][(l * 2 + 0) * 512 + c]);
    __syncthreads();
    sig[ch * 256 + t] = y1;
    __syncthreads();
    float acc2 = 0.f;
    for (int s = 0; s < 256; ++s) acc2 += ks[(1 * 2 + ch) * 512 + ((t - s) & 511)] * sig[ch * 256 + s];
    const float x2 = conv3(U + (size_t)(1024 + c) * HROWS, t, LCTX, cw[1024 + c], cw[1536 + 1024 + c], cw[3072 + 1024 + c], cb[1024 + c]);
    const float g = bf2f(U[(size_t)(1536 + c) * HROWS + t]);
    const float o = x2 * (acc2 + y1 * A.in[I_HBIAS][(l * 2 + 1) * 512 + c]) * siluf(g);
    bf16* Y = (bf16*)(F.ws + WS_Y) + ((size_t)hf * HROWS + HLAT + (size_t)bl * LCTX + t) * Y_LD + c;
    *Y = (bf16)f2bf(o);
}
typedef short bf16x8 __attribute__((ext_vector_type(8)));
constexpr int SP = 136;
__device__ __forceinline__ float softplusf(float x) { return x > 20.f ? x : log1pf(__expf(x)); }
__device__ __forceinline__ int slot_row0(int bl, int slot) { return slot < 2 ? HLAT + bl * LCTX + slot * 128 : bl * SEQ + (slot - 2) * 128; }
__device__ __forceinline__ bf16x8 frag16(const LAS bf16* base, int row0, int k0, int lane) { return *(const LAS bf16x8*)(base + (row0 + (lane & 15)) * SP + k0 + 8 * (lane >> 4)); }
#define MFMA16(a, b, c) __builtin_amdgcn_mfma_f32_16x16x32_bf16((a), (b), (c), 0, 0, 0)
__device__ __forceinline__ void ssd_prep_tile(Frame& F, const Args& A, int l, int bl, int slot) {
    F.refresh();
    const bf16* UR = (const bf16*)(F.ws + WS_UR); bf16* XBC = (bf16*)(F.ws + WS_XBC); float* DTA = (float*)(F.ws + WS_DTA);
    LAS float* das = (LAS float*)F.lds;
    const int r0 = slot_row0(bl, slot);
    const int seq0 = slot < 2 ? HLAT + bl * LCTX : bl * SEQ, seq1 = seq0 + (slot < 2 ? LCTX : SEQ);
    const float* cw = A.in[I_SCW] + (size_t)l * 3 * 1024; const float* cb = A.in[I_SCB] + (size_t)l * 1024;
    __syncthreads();
    { const int vec = F.tid & 127, c = vec * 8;
      float w0[8], w1[8], w2[8], b[8];
#pragma unroll
      for (int e = 0; e < 8; ++e) { w0[e] = cw[c + e]; w1[e] = cw[1024 + c + e]; w2[e] = cw[2048 + c + e]; b[e] = cb[c + e]; }
      const v4u zero4 = (v4u){0u, 0u, 0u, 0u};
#pragma unroll 2
      for (int i = 0; i < 32; ++i) { const int r = r0 + (F.tid >> 7) + 4 * i;
          const bf16* up = UR + (size_t)r * UR_LD + c;
          const v4u u0 = r > seq0 ? *(const v4u*)(up - UR_LD) : zero4, u1 = *(const v4u*)up, u2 = r < seq1 - 1 ? *(const v4u*)(up + UR_LD) : zero4;
          v4u o;
#pragma unroll
          for (int q = 0; q < 4; ++q) { const float lo = siluf(w0[2 * q] * bflo(u0[q]) + w1[2 * q] * bflo(u1[q]) + w2[2 * q] * bflo(u2[q]) + b[2 * q]);
              const float hi = siluf(w0[2 * q + 1] * bfhi(u0[q]) + w1[2 * q + 1] * bfhi(u1[q]) + w2[2 * q + 1] * bfhi(u2[q]) + b[2 * q + 1]); o[q] = pk2(lo, hi); }
          *(v4u*)(XBC + (size_t)r * 1024 + c) = o; } }
    { const int dh = F.tid & 15; const float a = -__expf(A.in[I_ALOG][l * 16 + dh]), dtb = A.in[I_DTB][l * 16 + dh];
#pragma unroll
      for (int i = 0; i < 4; ++i) { const int tt = (F.tid >> 4) + 32 * i; const float dtv = softplusf(bf2f(UR[(size_t)(r0 + tt) * UR_LD + UR_DT + dh]) + dtb);
          DTA[(size_t)(r0 + tt) * 32 + dh] = dtv; das[tt * 16 + dh] = dtv * a; } }
    __syncthreads();
    if (F.tid < 16) { float run = 0.f;
        if (F.tid < 8) { for (int tt = 0; tt < 128; ++tt) { run += das[tt * 16 + F.tid]; DTA[(size_t)(r0 + tt) * 32 + 16 + F.tid] = run; } }
        else { for (int tt = 127; tt >= 0; --tt) { run += das[tt * 16 + F.tid]; DTA[(size_t)(r0 + tt) * 32 + 16 + F.tid] = run; } } }
}
__device__ __forceinline__ void ssd_state_tile(Frame& F, int bl, int slot, int h) {
    F.refresh();
    const bf16* XBC = (const bf16*)(F.ws + WS_XBC); const float* DTA = (const float*)(F.ws + WS_DTA);
    LAS bf16* xTf = (LAS bf16*)F.lds;
    LAS bf16* xTb = xTf + 64 * SP;
    LAS bf16* BT = xTb + 64 * SP;
    const int r0 = slot_row0(bl, slot), g = h >> 2;
    __syncthreads();
#pragma unroll
    for (int i = 0; i < 2; ++i) { const int idx = F.tid + NTHR * i, s = idx >> 3, p0 = (idx & 7) * 8;
        const float* dr = DTA + (size_t)(r0 + s) * 32;
        const float wf = dr[h] * __expf(DTA[(size_t)(r0 + 127) * 32 + 16 + h] - dr[16 + h]);
        const float wb = dr[8 + h] * __expf(DTA[(size_t)r0 * 32 + 24 + h] - dr[24 + h]);
        const v4u u = *(const v4u*)(XBC + (size_t)(r0 + s) * 1024 + h * 64 + p0);
#pragma unroll
        for (int q = 0; q < 4; ++q) { const float lo = bflo(u[q]), hi = bfhi(u[q]);
            xTf[(p0 + 2 * q) * SP + s] = (bf16)f2bf(lo * wf); xTf[(p0 + 2 * q + 1) * SP + s] = (bf16)f2bf(hi * wf);
            xTb[(p0 + 2 * q) * SP + s] = (bf16)f2bf(lo * wb); xTb[(p0 + 2 * q + 1) * SP + s] = (bf16)f2bf(hi * wb); } }
#pragma unroll
    for (int i = 0; i < 4; ++i) { const int idx = F.tid + NTHR * i, s = idx >> 4, n0 = (idx & 15) * 8;
        const v4u u = *(const v4u*)(XBC + (size_t)(r0 + s) * 1024 + 512 + g * 128 + n0);
#pragma unroll
        for (int q = 0; q < 4; ++q) { BT[(n0 + 2 * q) * SP + s] = (bf16)(u[q] & 0xffffu); BT[(n0 + 2 * q + 1) * SP + s] = (bf16)(u[q] >> 16); } }
    __syncthreads();
    f32x4 acc[2][4];
#pragma unroll
    for (int d = 0; d < 2; ++d)
#pragma unroll
        for (int j = 0; j < 4; ++j) acc[d][j] = (f32x4){0.f, 0.f, 0.f, 0.f};
#pragma unroll
    for (int ks = 0; ks < 4; ++ks) { const bf16x8 a = frag16(BT, 16 * F.wave, 32 * ks, F.lane);
#pragma unroll
        for (int j = 0; j < 4; ++j) { acc[0][j] = MFMA16(a, frag16(xTf, 16 * j, 32 * ks, F.lane), acc[0][j]); acc[1][j] = MFMA16(a, frag16(xTb, 16 * j, 32 * ks, F.lane), acc[1][j]); } }
    bf16* ST = (bf16*)(F.ws + WS_STATE) + ((size_t)((bl * 34 + slot) * 8 + h) * 2) * 8192;
#pragma unroll
    for (int d = 0; d < 2; ++d)
#pragma unroll
        for (int j = 0; j < 4; ++j) { v2u o; o.x = pk2(acc[d][j][0], acc[d][j][1]); o.y = pk2(acc[d][j][2], acc[d][j][3]);
            *(v2u*)(ST + (size_t)d * 8192 + (16 * j + (F.lane & 15)) * 128 + 16 * F.wave + 4 * (F.lane >> 4)) = o; }
}
__device__ __forceinline__ void ssd_scan(Frame& F) {
    F.refresh();
    const float* DTA = (const float*)(F.ws + WS_DTA);
    unsigned* ST = (unsigned*)(F.ws + WS_STATE);
    for (int it = F.bid * NTHR + F.tid; it < 64 * 4096; it += F.G * NTHR) {
        const int e = it & 4095, chain = it >> 12, dir = chain & 1, h = (chain >> 1) & 7, bl = chain >> 4;
        float r0 = 0.f, r1 = 0.f;
        for (int i = 0; i < 34; ++i) {
            const int slot = dir == 0 ? i : (i < 2 ? 1 - i : 35 - i);
            unsigned* p = ST + (((size_t)((bl * 34 + slot) * 8 + h) * 2 + dir) * 8192) / 2 + e;
            const unsigned w = *p;
            const int rr = slot_row0(bl, slot) + (dir == 0 ? 127 : 0);
            const float dec = __expf(DTA[(size_t)rr * 32 + 16 + dir * 8 + h]);
            *p = pk2(r0, r1);
            r0 = r0 * dec + bflo(w); r1 = r1 * dec + bfhi(w);
        }
    }
}
__device__ __forceinline__ void ssd_out_tile(Frame& F, int bl, int slot, int h) {
    F.refresh();
    const bf16* XBC = (const bf16*)(F.ws + WS_XBC); const float* DTA = (const float*)(F.ws + WS_DTA);
    LAS bf16* Cs = (LAS bf16*)F.lds;
    LAS bf16* Bs = Cs + 128 * SP;
    LAS bf16* Mb = Bs + 128 * SP;
    LAS bf16* xT = Mb + 128 * SP;
    LAS bf16* St = xT + 64 * SP;
    LAS float* sc = (LAS float*)(St + 64 * SP);
    const int r0 = slot_row0(bl, slot), g = h >> 2;
    __syncthreads();
#pragma unroll
    for (int i = 0; i < 4; ++i) { const int idx = F.tid + NTHR * i, s = idx >> 4, n0 = (idx & 15) * 8;
        const bf16* src = XBC + (size_t)(r0 + s) * 1024 + 512 + g * 128 + n0;
        *(LAS v4u*)(Bs + s * SP + n0) = *(const v4u*)src; *(LAS v4u*)(Cs + s * SP + n0) = *(const v4u*)(src + 256); }
#pragma unroll
    for (int i = 0; i < 2; ++i) { const int idx = F.tid + NTHR * i, s = idx >> 3, p0 = (idx & 7) * 8;
        const v4u u = *(const v4u*)(XBC + (size_t)(r0 + s) * 1024 + h * 64 + p0);
#pragma unroll
        for (int q = 0; q < 4; ++q) { xT[(p0 + 2 * q) * SP + s] = (bf16)(u[q] & 0xffffu); xT[(p0 + 2 * q + 1) * SP + s] = (bf16)(u[q] >> 16); } }
    { const int s = F.tid & 127, k = F.tid >> 7; const float* dr = DTA + (size_t)(r0 + s) * 32;
      sc[k * 128 + s] = k == 0 ? dr[16 + h] : (k == 1 ? dr[24 + h] : (k == 2 ? dr[h] : dr[8 + h])); }
    __syncthreads();
    f32x4 gT[8];
#pragma unroll
    for (int j = 0; j < 8; ++j) gT[j] = (f32x4){0.f, 0.f, 0.f, 0.f};
#pragma unroll
    for (int ks = 0; ks < 4; ++ks) { const bf16x8 a = frag16(Bs, 16 * F.wave, 32 * ks, F.lane);
#pragma unroll
        for (int j = 0; j < 8; ++j) gT[j] = MFMA16(a, frag16(Cs, 16 * j, 32 * ks, F.lane), gT[j]); }
    f32x4 ysum[4];
#pragma unroll
    for (int j = 0; j < 4; ++j) ysum[j] = (f32x4){0.f, 0.f, 0.f, 0.f};
    const int s0 = 16 * F.wave + 4 * (F.lane >> 4);
#pragma unroll
    for (int dir = 0; dir < 2; ++dir) {
        { const bf16* stg = (const bf16*)(F.ws + WS_STATE) + (((size_t)((bl * 34 + slot) * 8 + h) * 2 + dir) * 8192);
#pragma unroll
          for (int i = 0; i < 2; ++i) { const int idx = F.tid + NTHR * i, p = idx >> 4, n0 = (idx & 15) * 8; *(LAS v4u*)(St + p * SP + n0) = *(const v4u*)(stg + p * 128 + n0); } }
        const LAS float* cum = sc + dir * 128; const LAS float* dts = sc + (2 + dir) * 128;
        float cs[4], ds[4];
#pragma unroll
        for (int e = 0; e < 4; ++e) { cs[e] = cum[s0 + e]; ds[e] = dts[s0 + e]; }
#pragma unroll
        for (int j = 0; j < 8; ++j) { const int lrow = 16 * j + (F.lane & 15); const float cl = cum[lrow]; float mv[4];
#pragma unroll
            for (int e = 0; e < 4; ++e) { const int s = s0 + e; const bool ok = dir == 0 ? (s <= lrow) : (s >= lrow); mv[e] = ok ? gT[j][e] * __expf(cl - cs[e]) * ds[e] : 0.f; }
            v2u o; o.x = pk2(mv[0], mv[1]); o.y = pk2(mv[2], mv[3]); *(LAS v2u*)(Mb + lrow * SP + s0) = o; }
        __syncthreads();
        f32x4 yd[4], yo[4];
#pragma unroll
        for (int j = 0; j < 4; ++j) { yd[j] = (f32x4){0.f, 0.f, 0.f, 0.f}; yo[j] = (f32x4){0.f, 0.f, 0.f, 0.f}; }
#pragma unroll
        for (int ks = 0; ks < 4; ++ks) { const bf16x8 am = frag16(Mb, 16 * F.wave, 32 * ks, F.lane), ac = frag16(Cs, 16 * F.wave, 32 * ks, F.lane);
#pragma unroll
            for (int j = 0; j < 4; ++j) { yd[j] = MFMA16(am, frag16(xT, 16 * j, 32 * ks, F.lane), yd[j]); yo[j] = MFMA16(ac, frag16(St, 16 * j, 32 * ks, F.lane), yo[j]); } }
#pragma unroll
        for (int e = 0; e < 4; ++e) { const float ex = __expf(cum[s0 + e]);
#pragma unroll
            for (int j = 0; j < 4; ++j) ysum[j][e] += yd[j][e] + ex * yo[j][e]; }
        __syncthreads();
    }
    float* YS = (float*)(F.ws + WS_YS) + (size_t)(r0 + s0) * 512 + h * 64 + (F.lane & 15);
#pragma unroll
    for (int e = 0; e < 4; ++e)
#pragma unroll
        for (int j = 0; j < 4; ++j) YS[(size_t)e * 512 + 16 * j] = ysum[j][e];
}
__device__ __forceinline__ void ssd_finish(Frame& F, const Args& A, int l, int hf, int nrows) {
    F.refresh();
    const int gw = F.bid * NWAVES + F.wave, NGW = F.G * NWAVES;
    const bf16* UR = (const bf16*)(F.ws + WS_UR); const bf16* XBC = (const bf16*)(F.ws + WS_XBC);
    const float* YS = (const float*)(F.ws + WS_YS);
    const int c = F.lane * 8;
    const float D = A.in[I_SD][l * 8 + (F.lane >> 3)];
    for (int r = gw; r < nrows; r += NGW) {
        const v4u xx = *(const v4u*)(XBC + (size_t)r * 1024 + c);
        const v4u zz = *(const v4u*)(UR + (size_t)r * UR_LD + UR_Z + c);
        const f32x4 y0 = *(const f32x4*)(YS + (size_t)r * 512 + c), y1 = *(const f32x4*)(YS + (size_t)r * 512 + c + 4);
        float y[8]; float ss = 0.f;
#pragma unroll
        for (int q = 0; q < 4; ++q) { const float ya = q < 2 ? y0[2 * q] : y1[2 * q - 4], yb = q < 2 ? y0[2 * q + 1] : y1[2 * q - 3];
            y[2 * q] = (ya + bflo(xx[q]) * D) * siluf(bflo(zz[q])); y[2 * q + 1] = (yb + bfhi(xx[q]) * D) * siluf(bfhi(zz[q]));
            ss += y[2 * q] * y[2 * q] + y[2 * q + 1] * y[2 * q + 1]; }
#pragma unroll
        for (int o = 1; o < 32; o <<= 1) ss += __shfl_xor(ss, o);
        const float rs = 1.f / sqrtf(ss * (1.f / 256.f) + 1e-5f);
        const float* nw = A.in[I_SNW] + l * 512 + c;
        v4u o4;
        o4.x = pk2(y[0] * rs * nw[0], y[1] * rs * nw[1]); o4.y = pk2(y[2] * rs * nw[2], y[3] * rs * nw[3]);
        o4.z = pk2(y[4] * rs * nw[4], y[5] * rs * nw[5]); o4.w = pk2(y[6] * rs * nw[6], y[7] * rs * nw[7]);
        *(v4u*)((bf16*)(F.ws + WS_Y) + ((size_t)hf * HROWS + r) * Y_LD + 512 + c) = o4;
    }
}
constexpr int KP = 72;
__device__ __forceinline__ void attn_tile(Frame& F, const Args& A, int l, int hf, int bl, int kvh, int qb, bool isctx, LAS bf16* Ks, LAS bf16* VT, const LAS f32x2* rope) {
    F.refresh();
    const bf16* UR = (const bf16*)(F.ws + WS_UR);
    const int g = F.wave >> 1, qh = F.wave & 1, hq = kvh * 4 + g, u = F.lane >> 4, c = F.lane & 15;
    const int rowbase = isctx ? HLAT + bl * LCTX : bl * SEQ;
    bf16x8 qf[4][2];
#pragma unroll
    for (int mi = 0; mi < 4; ++mi) { const int t = qb * 128 + qh * 64 + 16 * mi + c; const bf16* qp = UR + (size_t)(rowbase + t) * UR_LD + UR_Q + hq * 64;
#pragma unroll
        for (int ks = 0; ks < 2; ++ks) { const int d0 = 32 * ks + 8 * u, dp = (u < 2) ? d0 + 16 : d0 - 16;
            const v4u own = *(const v4u*)(qp + d0), par = *(const v4u*)(qp + dp);
            float o8[8];
#pragma unroll
            for (int e = 0; e < 4; ++e) { o8[2 * e] = bflo(own[e]); o8[2 * e + 1] = bfhi(own[e]); }
            if (!isctx) { const int pos = ks == 0 ? (t >> 6) : (t & 63);
#pragma unroll
                for (int e = 0; e < 8; ++e) { const float pv = (e & 1) ? bfhi(par[e >> 1]) : bflo(par[e >> 1]); const f32x2 r = rope[pos * 16 + 8 * (u & 1) + e];
                    o8[e] = (u < 2) ? (o8[e] * r.x - pv * r.y) : (pv * r.y + o8[e] * r.x); } }
            v4u pk;
#pragma unroll
            for (int e = 0; e < 4; ++e) pk[e] = pk2(o8[2 * e] * 0.125f, o8[2 * e + 1] * 0.125f);
            qf[mi][ks] = __builtin_bit_cast(bf16x8, pk); } }
    float mrun[4], lp[4];
    { const float sk = A.in[I_SINK][l * 8 + hq];
#pragma unroll
      for (int mi = 0; mi < 4; ++mi) { mrun[mi] = sk; lp[mi] = (u == 0) ? 1.f : 0.f; } }
    f32x4 oT[4][4];
#pragma unroll
    for (int nd = 0; nd < 4; ++nd)
#pragma unroll
        for (int mi = 0; mi < 4; ++mi) oT[nd][mi] = (f32x4){0.f, 0.f, 0.f, 0.f};
    for (int kt = isctx ? 3 : 0; kt < 5; ++kt) {
        const int jb = qb - 1 + kt;
        if (kt < 3 && (jb < 0 || jb >= SEQ / 128)) continue;
        const int krow0 = kt < 3 ? bl * SEQ + jb * 128 : HLAT + bl * LCTX + (kt - 3) * 128;
        __syncthreads();
        { const int row = F.tid >> 2, hs = (F.tid >> 1) & 1, sub = F.tid & 1, dlo = hs * 32 + sub * 8;
          const bf16* kp = UR + (size_t)(krow0 + row) * UR_LD + UR_K + kvh * 64 + dlo; const bf16* vp = kp + (UR_V - UR_K);
          const v4u k0 = *(const v4u*)kp, k1 = *(const v4u*)(kp + 16), v0 = *(const v4u*)vp, v1 = *(const v4u*)(vp + 16);
          if (kt < 3) { float ka[8], kb[8];
#pragma unroll
              for (int e = 0; e < 4; ++e) { ka[2 * e] = bflo(k0[e]); ka[2 * e + 1] = bfhi(k0[e]); kb[2 * e] = bflo(k1[e]); kb[2 * e + 1] = bfhi(k1[e]); }
              const int j = jb * 128 + row, pos = hs == 0 ? (j >> 6) : (j & 63);
#pragma unroll
              for (int e = 0; e < 8; ++e) { const f32x2 r = rope[pos * 16 + sub * 8 + e]; const float a = ka[e], b = kb[e]; ka[e] = a * r.x - b * r.y; kb[e] = a * r.y + b * r.x; }
              v4u o0, o1;
#pragma unroll
              for (int e = 0; e < 4; ++e) { o0[e] = pk2(ka[2 * e], ka[2 * e + 1]); o1[e] = pk2(kb[2 * e], kb[2 * e + 1]); }
              *(LAS v4u*)(Ks + row * KP + dlo) = o0; *(LAS v4u*)(Ks + row * KP + dlo + 16) = o1;
          } else { *(LAS v4u*)(Ks + row * KP + dlo) = k0; *(LAS v4u*)(Ks + row * KP + dlo + 16) = k1; }
#pragma unroll
          for (int e = 0; e < 4; ++e) { VT[(dlo + 2 * e) * SP + row] = (bf16)(v0[e] & 0xffffu); VT[(dlo + 2 * e + 1) * SP + row] = (bf16)(v0[e] >> 16);
              VT[(dlo + 16 + 2 * e) * SP + row] = (bf16)(v1[e] & 0xffffu); VT[(dlo + 16 + 2 * e + 1) * SP + row] = (bf16)(v1[e] >> 16); } }
        __syncthreads();
#pragma unroll 1
        for (int hh = 0; hh < 2; ++hh) {
            const int kl0 = 64 * hh;
            f32x4 sT[4][4];
#pragma unroll
            for (int nj = 0; nj < 4; ++nj)
#pragma unroll
                for (int mi = 0; mi < 4; ++mi) sT[nj][mi] = (f32x4){0.f, 0.f, 0.f, 0.f};
#pragma unroll
            for (int ks = 0; ks < 2; ++ks)
#pragma unroll
                for (int nj = 0; nj < 4; ++nj) { const bf16x8 a = *(const LAS bf16x8*)(Ks + (kl0 + 16 * nj + c) * KP + 32 * ks + 8 * u);
#pragma unroll
                    for (int mi = 0; mi < 4; ++mi) sT[nj][mi] = MFMA16(a, qf[mi][ks], sT[nj][mi]); }
            if (kt == 0 || kt == 2) {
#pragma unroll
                for (int nj = 0; nj < 4; ++nj)
#pragma unroll
                    for (int mi = 0; mi < 4; ++mi) { const int ql = qh * 64 + 16 * mi + c;
#pragma unroll
                        for (int e = 0; e < 4; ++e) { const int kl = kl0 + 16 * nj + 4 * u + e; const bool bad = kt == 0 ? (kl < ql) : (kl > ql); if (bad) sT[nj][mi][e] = -INFINITY; } }
            }
#pragma unroll
            for (int mi = 0; mi < 4; ++mi) {
                float mx = -INFINITY;
#pragma unroll
                for (int nj = 0; nj < 4; ++nj) mx = fmaxf(fmaxf(mx, fmaxf(sT[nj][mi][0], sT[nj][mi][1])), fmaxf(sT[nj][mi][2], sT[nj][mi][3]));
                mx = fmaxf(mx, __shfl_xor(mx, 16)); mx = fmaxf(mx, __shfl_xor(mx, 32));
                const float mn = fmaxf(mrun[mi], mx), alpha = __expf(mrun[mi] - mn); mrun[mi] = mn;
                float ls = 0.f;
#pragma unroll
                for (int nj = 0; nj < 4; ++nj)
#pragma unroll
                    for (int e = 0; e < 4; ++e) { const float p = __expf(sT[nj][mi][e] - mn); sT[nj][mi][e] = p; ls += p; }
                lp[mi] = lp[mi] * alpha + ls;
#pragma unroll
                for (int nd = 0; nd < 4; ++nd) oT[nd][mi] = oT[nd][mi] * alpha;
            }
#pragma unroll
            for (int kk = 0; kk < 2; ++kk) {
                bf16x8 pb[4];
#pragma unroll
                for (int mi = 0; mi < 4; ++mi) { v4u pk; pk.x = pk2(sT[2 * kk][mi][0], sT[2 * kk][mi][1]); pk.y = pk2(sT[2 * kk][mi][2], sT[2 * kk][mi][3]);
                    pk.z = pk2(sT[2 * kk + 1][mi][0], sT[2 * kk + 1][mi][1]); pk.w = pk2(sT[2 * kk + 1][mi][2], sT[2 * kk + 1][mi][3]); pb[mi] = __builtin_bit_cast(bf16x8, pk); }
#pragma unroll
                for (int nd = 0; nd < 4; ++nd) { const LAS bf16* vr = VT + (16 * nd + c) * SP + kl0 + 32 * kk + 4 * u;
                    const v2u a0 = *(const LAS v2u*)vr, a1 = *(const LAS v2u*)(vr + 16);
                    const bf16x8 a = __builtin_bit_cast(bf16x8, ((v4u){a0.x, a0.y, a1.x, a1.y}));
#pragma unroll
                    for (int mi = 0; mi < 4; ++mi) oT[nd][mi] = MFMA16(a, pb[mi], oT[nd][mi]); }
            }
        }
    }
#pragma unroll
    for (int mi = 0; mi < 4; ++mi) {
        float ls = lp[mi]; ls += __shfl_xor(ls, 16); ls += __shfl_xor(ls, 32);
        const float inv = 1.f / ls;
        const int t = qb * 128 + qh * 64 + 16 * mi + c, qrow = rowbase + t;
        const bf16* zp = UR + (size_t)qrow * UR_LD + UR_ZA + hq * 64 + 4 * u;
        bf16* yp = (bf16*)(F.ws + WS_Y) + ((size_t)hf * HROWS + qrow) * Y_LD + 1024 + hq * 64 + 4 * u;
#pragma unroll
        for (int nd = 0; nd < 4; ++nd) { const v2u zw = *(const v2u*)(zp + 16 * nd); const f32x4 o = oT[nd][mi] * inv; v2u ow;
            ow.x = pk2(o[0] * siluf(bflo(zw.x)), o[1] * siluf(bfhi(zw.x))); ow.y = pk2(o[2] * siluf(bflo(zw.y)), o[3] * siluf(bfhi(zw.y)));
            *(v2u*)(yp + 16 * nd) = ow; }
    }
}
__device__ __forceinline__ void phase3(Frame& F, const Args& A, int l, int hf, unsigned* ctr) {
    F.refresh();
    for (int it = F.bid; it < 136; it += F.G) ssd_prep_tile(F, A, l, it / 34, it % 34);
    LAS f32x2* buf = (LAS f32x2*)F.lds; LAS f32x2* tw = buf + FFT_BUF_ELEMS;
    LAS float* cks = (LAS float*)(F.lds + 100352); LAS float* csig = cks + 2048;
    LAS bf16* Ks = (LAS bf16*)F.lds; LAS bf16* Vs = Ks + 128 * KP; LAS f32x2* rope = (LAS f32x2*)(Vs + 64 * SP);
    const int n_hy = 1024, n_hc = (l == 0) ? 1024 : 0, n_at = 256, n_ac = (l == 0) ? 16 : 0;
    const int total = n_hy + n_hc + n_at + n_ac;
    bool tw_loaded = false, rope_loaded = false;
    for (;;) {
        int tile = next_tile(F, ctr);
        if (tile >= total) break;
        if (tile < n_hy) { if (!tw_loaded) { load_tw(F, tw); tw_loaded = true; } hyena_tile(F, A, l, hf, tile & 3, tile >> 2, buf, tw); continue; }
        tile -= n_hy;
        if (tile < n_hc) { hyena_ctx_tile(F, A, hf, tile & 3, tile >> 2, cks, csig); continue; }
        tile -= n_hc;
        if (!rope_loaded) { __syncthreads(); const f32x2* gr = (const f32x2*)(F.ws + WS_ROPE); for (int j = F.tid; j < 1024; j += NTHR) rope[j] = gr[j]; rope_loaded = true; __syncthreads(); }
        if (tile < n_at) { attn_tile(F, A, l, hf, tile >> 6, (tile >> 5) & 1, tile & 31, false, Ks, Vs, rope); continue; }
        tile -= n_at;
        attn_tile(F, A, l, hf, tile >> 2, (tile >> 1) & 1, tile & 1, true, Ks, Vs, rope);
    }
    __syncthreads();
}

__device__ __forceinline__ void phase5(Frame& F, const Args& A, int l) {
    F.refresh();
    const int gw = F.bid * NWAVES + F.wave, NGW = F.G * NWAVES;
    const float* T = (const float*)(F.ws + WS_T);
    const float* MOD = (const float*)(F.ws + WS_MOD);
    const float* lg = A.in[I_LNG] + l * 1024; const float* lb = A.in[I_LNB] + l * 1024;
    for (int m = gw; m < MTOT; m += NGW) {
        int islat, b, t; row_map(m, islat, b, t);
        if (l == 1 && !islat) continue;
        f32x4 v[4];
#pragma unroll
        for (int j = 0; j < 4; ++j) v[j] = *((const f32x4*)(T + (size_t)m * DM) + F.lane + 64 * j);
        float mean, rstd; ln_stats(v, mean, rstd, 1e-6f);
#pragma unroll
        for (int j = 0; j < 4; ++j) v[j] = (v[j] - mean) * rstd * *((const f32x4*)lg + F.lane + 64 * j) + *((const f32x4*)lb + F.lane + 64 * j);
        if (islat) { f32x4* o = (f32x4*)(F.out + ((size_t)b * SEQ + t) * DM) + F.lane;
#pragma unroll
            for (int j = 0; j < 4; ++j) o[64 * j] = v[j]; }
        if (l == 0) ln_mod_store(v, MOD + (size_t)(1 * 9 + (islat ? b : 8)) * 3072, (bf16*)(F.ws + WS_XN) + (size_t)m * DM, F.lane);
    }
}

#ifndef REP_PRE
#define REP_PRE 1
#endif
#ifndef REP_GEMM
#define REP_GEMM 1
#endif
#ifndef REP_P3
#define REP_P3 1
#endif
#ifndef REP_SSD
#define REP_SSD 1
#endif
#ifndef REP_P5
#define REP_P5 1
#endif
__global__ void __launch_bounds__(NTHR, 2) fwd_megakernel(Args args) {
    extern __shared__ __attribute__((aligned(16))) unsigned char lds_raw[];
    Frame F;
    F.lds = (LAS unsigned char*)lds_raw;
    F.tid = threadIdx.x; F.lane = F.tid & 63; F.wave = __builtin_amdgcn_readfirstlane(F.tid >> 6);
    F.bid = blockIdx.x; F.G = gridDim.x; F.out = args.out; F.ws = args.ws;
    for (int u = F.tid; u < (LDS_BYTES - LDSCTL_OFF) / 4; u += NTHR) ((LAS unsigned*)(F.lds + LDSCTL_OFF))[u] = 0u;
    __syncthreads();
    unsigned* ctl = (unsigned*)(F.ws + WS_CTL);
    XcdBarrier bar = xcd_barrier_post(ctl + CW_BAR, (volatile LAS unsigned*)(F.lds + LDSCTL_OFF));
#define GRID_BAR() xcd_barrier(bar)
#pragma unroll
    for (int rep = 0; rep < REP_PRE; ++rep) {
    phase0(F, args); GRID_BAR();
    phase1(F, args); GRID_BAR();
    phase1b(F); GRID_BAR();
    }
#pragma unroll
    for (int l = 0; l < 2; ++l) {
#pragma unroll
        for (int hf = 0; hf < 2; ++hf) {
#pragma unroll
            for (int rep = 0; rep < REP_GEMM; ++rep)
            {
                const pg8::bf16_t* XNh = (const pg8::bf16_t*)(F.ws + WS_XN) + (size_t)hf * HROWS * DM;
                { pg8::Gemm g{(const pg8::bf16_t*)(F.ws + WS_WHY) + (size_t)l * 2048 * 1024, XNh, 2048, HROWS, DM}; pg8::StaticOrder S; S.init(2048, HROWS, F.G, F.bid);
                  pg8::EpiBf16 E{(pg8::bf16_t*)(F.ws + WS_UHY), HROWS};
                  pg8::gemm_phase<pg8::EpiBf16, pg8::StaticOrder, true, true>(F.lds, g, S, E); }
                { pg8::Gemm g{XNh, (const pg8::bf16_t*)(F.ws + WS_WR) + (size_t)l * 3072 * 1024, HROWS, UR_LD, DM}; pg8::StaticOrder S; S.init(HROWS, UR_LD, F.G, F.bid);
                  pg8::EpiBf16 E{(pg8::bf16_t*)(F.ws + WS_UR), UR_LD};
                  pg8::gemm_phase<pg8::EpiBf16, pg8::StaticOrder, true, true>(F.lds, g, S, E); }
            }
            GRID_BAR();
#pragma unroll
            for (int rep = 0; rep < REP_P3; ++rep) { phase3(F, args, l, hf, ctl + CW_CTR + 64 * (l * 2 + hf + 4 * rep)); GRID_BAR(); }
#pragma unroll
            for (int rep = 0; rep < REP_SSD; ++rep) { for (int it = F.bid; it < 1088; it += F.G) ssd_state_tile(F, it / 272, (it >> 3) % 34, it & 7);
            GRID_BAR(); }
            ssd_scan(F); GRID_BAR();
#pragma unroll
            for (int rep = 0; rep < REP_SSD; ++rep) {
            for (int it = F.bid; it < 1088; it += F.G) { const int slot = (it >> 3) % 34; if (l == 1 && slot < 2) continue; ssd_out_tile(F, it / 272, slot, it & 7); }
            GRID_BAR();
            ssd_finish(F, args, l, hf, l == 0 ? HROWS : HLAT); GRID_BAR(); }
        }
#pragma unroll
        for (int rep = 0; rep < REP_GEMM; ++rep)
        {
            pg8::Gemm g{(const pg8::bf16_t*)(F.ws + WS_Y), (const pg8::bf16_t*)(F.ws + WS_WO) + (size_t)l * 1024 * 1536, MTOT, DM, 1536};
            pg8::EpiRes E{l == 0 ? args.in[I_X] : F.out, args.in[I_CTX], (const float*)(F.ws + WS_MOD), (float*)(F.ws + WS_T), l};
            if (l == 0) { pg8::StaticOrder S; S.init(MTOT, DM, F.G, F.bid); pg8::gemm_phase<pg8::EpiRes, pg8::StaticOrder, true, true>(F.lds, g, S, E); }
            else { pg8::OrderLat S; S.S.init(2 * HLAT, DM, F.G, F.bid); pg8::gemm_phase<pg8::EpiRes, pg8::OrderLat, true, true>(F.lds, g, S, E); }
        }
        GRID_BAR();
#pragma unroll
        for (int rep = 0; rep < REP_P5; ++rep) { if (rep) GRID_BAR(); phase5(F, args, l); }
        if (l == 0) GRID_BAR();
    }
}

extern "C" void kernel_launch(void* const* d_in, const int* in_sizes, int n_in, void* d_out, int out_size, void* d_ws, size_t ws_size, hipStream_t stream) {
    static int grid = 0;
    if (grid == 0) {
        if (n_in != 28 || out_size != NBATCH * SEQ * DM || ws_size < WS_END) { fprintf(stderr, "kernel_launch: unexpected problem (n_in %d, out %d, ws %zu); nothing launched\n", n_in, out_size, ws_size); grid = -1; return; }
        int dev = 0, cus = 0, per_cu = 0;
        if (hipGetDevice(&dev) != hipSuccess || hipDeviceGetAttribute(&cus, hipDeviceAttributeMultiprocessorCount, dev) != hipSuccess) { grid = -1; return; }
        if (hipFuncSetAttribute((const void*)fwd_megakernel, hipFuncAttributeMaxDynamicSharedMemorySize, LDS_BYTES) != hipSuccess) { fprintf(stderr, "kernel_launch: hipFuncSetAttribute failed\n"); grid = -1; return; }
        if (hipOccupancyMaxActiveBlocksPerMultiprocessor(&per_cu, (const void*)fwd_megakernel, NTHR, LDS_BYTES) != hipSuccess || per_cu < 1) { fprintf(stderr, "kernel_launch: occupancy query says %d blocks per CU\n", per_cu); grid = -1; return; }
        (void)hipGetLastError();
        grid = cus;
    }
    if (grid < 0) return;
    (void)hipMemsetAsync((char*)d_ws + WS_CTL, 0, CTL_ZERO_BYTES, stream);
    Args a{};
    for (int i = 0; i < 28; ++i) a.in[i] = (const float*)d_in[i];
    a.out = (float*)d_out; a.ws = (unsigned char*)d_ws; a.ph_lo = 0; a.ph_hi = 0;
    void* kargs[] = {&a};
    hipError_t e = hipLaunchCooperativeKernel((const void*)fwd_megakernel, dim3(grid), dim3(NTHR), kargs, LDS_BYTES, stream);
    if (e != hipSuccess) fprintf(stderr, "kernel_launch: cooperative launch failed: %s (grid %d)\n", hipGetErrorString(e), grid);
}
```
